# Optimizing an MI355X kernel written in HIP

```python
import math
import jax, jax.numpy as jnp
from jax import lax
import numpy as np


D_MODEL = 1024
BATCH = 8
SEQ = 4096
DEPTH = 2

SSM_GROUP = 16
N_GROUPS = D_MODEL // SSM_GROUP
SSM_STATE = 64
DT_MIN = 1e-3
DT_MAX = 1e-1
N_HEADS = 8
QK_NOPE = 128
QK_ROPE = 64
V_HEAD = 128
Q_LORA = 384
KV_LORA = 256
ROPE_THETA = 10000.0
Q_BLOCK = 128
SM_SCALE = (QK_NOPE + QK_ROPE) ** -0.5
NEG_INF = -1e30
D_FF = 4 * D_MODEL
N_A_LAYERS = DEPTH // 2
N_B_LAYERS = DEPTH - N_A_LAYERS
DN_ALPHA = (2 * DEPTH) ** 0.25
DN_BETA = (8 * DEPTH) ** -0.25
LN_EPS = 1e-5
RMS_EPS = 1e-6

kernel_name = 'yoco_s5_mla_sqrelu_deepnorm'


def layer_norm(x, g, b):
    xf = x.astype(jnp.float32)
    mu = jnp.mean(xf, axis=-1, keepdims=True)
    var = jnp.mean(jnp.square(xf - mu), axis=-1, keepdims=True)
    y = (xf - mu) * lax.rsqrt(var + LN_EPS) * g.astype(jnp.float32) + b.astype(jnp.float32)
    return y.astype(x.dtype)


def rms_norm(x, g):
    xf = x.astype(jnp.float32)
    y = xf * lax.rsqrt(jnp.mean(jnp.square(xf), axis=-1, keepdims=True) + RMS_EPS) * g.astype(jnp.float32)
    return y.astype(x.dtype)


def rope_tables(positions):
    half = QK_ROPE // 2
    inv_freq = ROPE_THETA ** (-jnp.arange(half, dtype=jnp.float32) / half)
    ang = positions.astype(jnp.float32)[..., None] * inv_freq
    return jnp.cos(ang), jnp.sin(ang)


def apply_rope(x, cos, sin):
    x1, x2 = jnp.split(x.astype(jnp.float32), 2, axis=-1)
    return jnp.concatenate([x1 * cos - x2 * sin, x1 * sin + x2 * cos], axis=-1).astype(x.dtype)


def _complex_linear_combine(left, right):
    ar_l, ai_l, hr_l, hi_l = left
    ar_r, ai_r, hr_r, hi_r = right
    return (ar_r * ar_l - ai_r * ai_l,
            ar_r * ai_l + ai_r * ar_l,
            ar_r * hr_l - ai_r * hi_l + hr_r,
            ar_r * hi_l + ai_r * hr_l + hi_r)


def s5_mixer(x, lam_re, lam_im, log_dt, b_re, b_im, c_re, c_im, d_skip, w_glu, w_out):
    f32 = jnp.float32
    bsz, seq, _ = x.shape
    u = x.astype(f32).reshape(bsz, seq, N_GROUPS, SSM_GROUP)
    lr = lam_re.astype(f32)
    li = lam_im.astype(f32)
    dt = jnp.exp(log_dt.astype(f32))[:, None]
    mag = jnp.exp(lr * dt)
    a_re = mag * jnp.cos(li * dt)
    a_im = mag * jnp.sin(li * dt)
    inv_den = 1.0 / (lr * lr + li * li)
    coef_re = ((a_re - 1.0) * lr + a_im * li) * inv_den
    coef_im = (a_im * lr - (a_re - 1.0) * li) * inv_den
    br = b_re.astype(f32)
    bi = b_im.astype(f32)
    bb_re = coef_re[..., None] * br - coef_im[..., None] * bi
    bb_im = coef_re[..., None] * bi + coef_im[..., None] * br
    bu_re = jnp.einsum('bsgc,gpc->bsgp', u, bb_re)
    bu_im = jnp.einsum('bsgc,gpc->bsgp', u, bb_im)
    shape_a = (1, seq, N_GROUPS, SSM_STATE)
    a_re_t = jnp.broadcast_to(a_re, shape_a)
    a_im_t = jnp.broadcast_to(a_im, shape_a)
    _, _, h_re, h_im = lax.associative_scan(
        _complex_linear_combine, (a_re_t, a_im_t, bu_re, bu_im), axis=1)
    y = (jnp.einsum('bsgp,gcp->bsgc', h_re, c_re.astype(f32))
         - jnp.einsum('bsgp,gcp->bsgc', h_im, c_im.astype(f32)))
    y = y + d_skip.astype(f32).reshape(N_GROUPS, SSM_GROUP) * u
    y = jax.nn.gelu(y.reshape(bsz, seq, D_MODEL)).astype(x.dtype)
    val, gate = jnp.split(y @ w_glu, 2, axis=-1)
    return (val * jax.nn.sigmoid(gate)) @ w_out


def mla_shared_kv(h, kv_w_a, kv_norm_g, kv_w_b, cos, sin):
    bsz, seq, _ = h.shape
    c_kv, k_rope = jnp.split(h @ kv_w_a, [KV_LORA], axis=-1)
    c_kv = rms_norm(c_kv, kv_norm_g)
    k_rope = apply_rope(k_rope, cos, sin)
    kv = (c_kv @ kv_w_b).reshape(bsz, seq, N_HEADS, QK_NOPE + V_HEAD)
    k_nope, v = jnp.split(kv, [QK_NOPE], axis=-1)
    return k_nope, k_rope, v


def mla_mixer(h, q_w_a, q_norm_g, q_w_b, w_o, k_nope, k_rope, v, cos, sin):
    bsz, seq, _ = h.shape
    c_q = rms_norm(h @ q_w_a, q_norm_g)
    q = (c_q @ q_w_b).reshape(bsz, seq, N_HEADS, QK_NOPE + QK_ROPE)
    q_nope, q_rope = jnp.split(q, [QK_NOPE], axis=-1)
    q_rope = apply_rope(q_rope, cos[:, :, None, :], sin[:, :, None, :])
    n_blocks = seq // Q_BLOCK

    def to_blocks(t):
        return t.reshape(bsz, n_blocks, Q_BLOCK, *t.shape[2:]).swapaxes(0, 1)

    key_pos = jnp.arange(seq)

    def attend_block(args):
        blk, qn, qr = args
        s = (jnp.einsum('bqhd,bkhd->bhqk', qn, k_nope, preferred_element_type=jnp.float32)
             + jnp.einsum('bqhr,bkr->bhqk', qr, k_rope, preferred_element_type=jnp.float32)) * SM_SCALE
        q_pos = blk * Q_BLOCK + jnp.arange(Q_BLOCK)
        s = jnp.where(key_pos[None, :] <= q_pos[:, None], s, NEG_INF)
        p = jax.nn.softmax(s, axis=-1).astype(v.dtype)
        return jnp.einsum('bhqk,bkhd->bqhd', p, v)

    o = lax.map(attend_block, (jnp.arange(n_blocks), to_blocks(q_nope), to_blocks(q_rope)))
    o = o.swapaxes(0, 1).reshape(bsz, seq, N_HEADS * V_HEAD)
    return o @ w_o


def sq_relu_mlp(h, w1, w2):
    return jnp.square(jax.nn.relu(h @ w1)) @ w2


def setup_inputs(seed: int = 0) -> dict:
    key = jax.random.key(seed)
    k = jax.random.split(key, 24)
    f32 = jnp.float32

    def nrm(i, shape, scale):
        return jax.random.normal(k[i], shape, f32) * scale

    n_idx = jnp.arange(SSM_STATE, dtype=f32)
    return {
        'x': nrm(0, (BATCH, SEQ, D_MODEL), 1.0),
        'positions': jnp.broadcast_to(jnp.arange(SEQ, dtype=jnp.int32), (BATCH, SEQ)),
        'ln_mix_g': 1.0 + nrm(1, (DEPTH, D_MODEL), 0.02),
        'ln_mix_b': nrm(2, (DEPTH, D_MODEL), 0.02),
        'ln_ffn_g': 1.0 + nrm(3, (DEPTH, D_MODEL), 0.02),
        'ln_ffn_b': nrm(4, (DEPTH, D_MODEL), 0.02),
        'w_ff1': nrm(5, (DEPTH, D_MODEL, D_FF), D_MODEL ** -0.5),
        'w_ff2': nrm(6, (DEPTH, D_FF, D_MODEL), D_FF ** -0.5 * DN_BETA),
        'ssm_lam_re': -0.5 + nrm(7, (N_A_LAYERS, N_GROUPS, SSM_STATE), 0.01),
        'ssm_lam_im': math.pi * n_idx + nrm(8, (N_A_LAYERS, N_GROUPS, SSM_STATE), 0.01),
        'ssm_log_dt': jax.random.uniform(k[9], (N_A_LAYERS, N_GROUPS), f32, math.log(DT_MIN), math.log(DT_MAX)),
        'ssm_b_re': nrm(10, (N_A_LAYERS, N_GROUPS, SSM_STATE, SSM_GROUP), (2 * SSM_GROUP) ** -0.5),
        'ssm_b_im': nrm(11, (N_A_LAYERS, N_GROUPS, SSM_STATE, SSM_GROUP), (2 * SSM_GROUP) ** -0.5),
        'ssm_c_re': nrm(12, (N_A_LAYERS, N_GROUPS, SSM_GROUP, SSM_STATE), SSM_STATE ** -0.5),
        'ssm_c_im': nrm(13, (N_A_LAYERS, N_GROUPS, SSM_GROUP, SSM_STATE), SSM_STATE ** -0.5),
        'ssm_d': nrm(14, (N_A_LAYERS, D_MODEL), 1.0),
        'ssm_w_glu': nrm(15, (N_A_LAYERS, D_MODEL, 2 * D_MODEL), D_MODEL ** -0.5),
        'ssm_w_out': nrm(16, (N_A_LAYERS, D_MODEL, D_MODEL), D_MODEL ** -0.5 * DN_BETA),
        'kv_w_a': nrm(17, (D_MODEL, KV_LORA + QK_ROPE), D_MODEL ** -0.5),
        'kv_norm_g': 1.0 + nrm(18, (KV_LORA,), 0.02),
        'kv_w_b': nrm(19, (KV_LORA, N_HEADS * (QK_NOPE + V_HEAD)), KV_LORA ** -0.5),
        'q_w_a': nrm(20, (N_B_LAYERS, D_MODEL, Q_LORA), D_MODEL ** -0.5),
        'q_norm_g': 1.0 + nrm(21, (N_B_LAYERS, Q_LORA), 0.02),
        'q_w_b': nrm(22, (N_B_LAYERS, Q_LORA, N_HEADS * (QK_NOPE + QK_ROPE)), Q_LORA ** -0.5),
        'attn_w_o': nrm(23, (N_B_LAYERS, N_HEADS * V_HEAD, D_MODEL), (N_HEADS * V_HEAD) ** -0.5 * DN_BETA),
    }


def reference(x, positions, ln_mix_g, ln_mix_b, ln_ffn_g, ln_ffn_b, w_ff1, w_ff2,
              ssm_lam_re, ssm_lam_im, ssm_log_dt, ssm_b_re, ssm_b_im, ssm_c_re, ssm_c_im,
              ssm_d, ssm_w_glu, ssm_w_out, kv_w_a, kv_norm_g, kv_w_b,
              q_w_a, q_norm_g, q_w_b, attn_w_o):
    cos, sin = rope_tables(positions)
    h = x
    k_nope = k_rope = v = None
    for layer in range(DEPTH):
        if layer < N_A_LAYERS:
            i = layer
            mix = s5_mixer(h, ssm_lam_re[i], ssm_lam_im[i], ssm_log_dt[i], ssm_b_re[i], ssm_b_im[i],
                           ssm_c_re[i], ssm_c_im[i], ssm_d[i], ssm_w_glu[i], ssm_w_out[i])
        else:
            if layer == N_A_LAYERS:
                k_nope, k_rope, v = mla_shared_kv(h, kv_w_a, kv_norm_g, kv_w_b, cos, sin)
            j = layer - N_A_LAYERS
            mix = mla_mixer(h, q_w_a[j], q_norm_g[j], q_w_b[j], attn_w_o[j], k_nope, k_rope, v, cos, sin)
        h = layer_norm(DN_ALPHA * h + mix, ln_mix_g[layer], ln_mix_b[layer])
        h = layer_norm(DN_ALPHA * h + sq_relu_mlp(h, w_ff1[layer], w_ff2[layer]), ln_ffn_g[layer], ln_ffn_b[layer])
    return h
```

```cpp
#include <hip/hip_runtime.h>
#include <hip/hip_bf16.h>
#include <hip/hip_cooperative_groups.h>
#include <cstdio>
#include <cstdint>
namespace cg = cooperative_groups;

namespace pg8 {
#define PG8_LAS __attribute__((address_space(3)))
typedef unsigned short bf16_t;
typedef short bf16x8 __attribute__((ext_vector_type(8)));
typedef float f32x4 __attribute__((ext_vector_type(4)));
typedef float f32x2 __attribute__((ext_vector_type(2)));
typedef unsigned u32x4 __attribute__((ext_vector_type(4)));
constexpr int BM = 256, BK = 64, HALF = 128, HTB = HALF * BK * 2, STAGE_BYTES = 8 * HTB, NXCD = 8, WGM = 8;

__host__ __device__ __forceinline__ int lds_byte(int r, int c) { const int st = (r >> 4) * 2 + (c >> 5), rr = r & 15, cc = c & 31, ob = rr * 64 + cc * 2; return st * 1024 + (ob ^ (((ob >> 9) & 1) << 5)); }
__host__ __device__ __forceinline__ void stage_rc(int b, int& R, int& C) { const int st = b / 1024, sb = b % 1024, swz = sb ^ (((sb >> 9) & 1) << 5); R = (st >> 1) * 16 + swz / 64; C = (st & 1) * 32 + (swz % 64) / 2; }
__host__ __device__ __forceinline__ int perm32(int rho) { const int n = rho >> 4, i = rho & 15; return 8 * (i >> 2) + 4 * n + (i & 3); }

struct Unit { int pm, pn; };
struct Gemm { const bf16_t* A; const bf16_t* Bt; int K, lda, ldb; unsigned tstepA, tstepB; };

struct StaticOrder {
    int nM, nN, nwg, G, c;
    __device__ void init(int M, int N, int G_, int c_) { nM = M / BM; nN = N / BM; nwg = nM * nN; G = G_; c = c_; }
    __device__ bool next(int i, Unit& u) const {
        const long L = (long)i * G + c; if (L >= nwg) return false;
        int wgid = (int)L; { const int q = nwg / NXCD, r = nwg % NXCD, xcd = wgid % NXCD, off = wgid / NXCD; wgid = (xcd < r ? xcd * (q + 1) : r * (q + 1) + (xcd - r) * q) + off; }
        const int nig = WGM * nN, gid = wgid / nig, fm = gid * WGM, gsz = (nM - fm) < WGM ? (nM - fm) : WGM;
        u.pm = fm + ((wgid % nig) % gsz); u.pn = (wgid % nig) / gsz; return true;
    }
};
struct BatchOrder {
    int nwg, G, c, mper, nper;
    __device__ void init(int ngroups, int mper_, int nper_, int G_, int c_) { mper = mper_; nper = nper_; nwg = ngroups * mper_ * nper_; G = G_; c = c_; }
    __device__ bool next(int i, Unit& u) const {
        const int L = i * G + c; if (L >= nwg) return false;
        const int per = mper * nper, g = L / per, r = L % per;
        u.pm = g * mper + r / nper; u.pn = g * nper + r % nper; return true;
    }
};

__device__ __forceinline__ unsigned cvt_pk_bf16(float lo, float hi) { unsigned r; asm volatile("v_cvt_pk_bf16_f32 %0, %1, %2" : "=v"(r) : "v"(lo), "v"(hi)); return r; }

typedef f32x4 Acc[2][2][4][2];

template <class Epi, class Sched, bool ALIGN_EPI>
__device__ __forceinline__ void gemm_phase(PG8_LAS unsigned char* lds, const Gemm g, const Sched& S, const Epi& E) {
    int tid_ = threadIdx.x; asm volatile("" : "+v"(tid_));
    const int tid = tid_, wid = __builtin_amdgcn_readfirstlane(tid >> 6), lane = tid & 63, wr = wid >> 2, wc = wid & 3, fr = lane & 15, fq = lane >> 4;
    const int K = g.K, nt = K / BK;
    unsigned voffA[2], voffB[2];
#pragma unroll
    for (int i = 0; i < 2; ++i) { int R, C; stage_rc(tid * 16 + i * 8192, R, C); const int Rb = Epi::PERM ? ((R & ~31) + perm32(R & 31)) : R;
        voffA[i] = (unsigned)(R * g.lda + C) * 2u; voffB[i] = (unsigned)(Rb * g.ldb + C) * 2u; }
    const size_t kstep = (size_t)(BK * 2);
    const size_t hstepA = (size_t)HALF * g.lda * 2, hstepB = (size_t)HALF * g.ldb * 2;
    const unsigned ldsw = (unsigned)wid * 1024u;
    const int aoff = lds_byte(wr * 64 + fr, fq * 8), boff = lds_byte(wc * 32 + fr, fq * 8);
#define PG8_SA(b, h) (((b) * 2 + (h)) * HTB)
#define PG8_SB(b, h) ((4 + (b) * 2 + (h)) * HTB)
#define PG8_STAGE(bufoff, gbase, voff) do { _Pragma("unroll") for (int _i = 0; _i < 2; ++_i) \
        __builtin_amdgcn_global_load_lds((const unsigned*)((const char*)(gbase) + (voff)[_i]), (PG8_LAS unsigned*)(lds + (bufoff) + ldsw + _i * 8192), 16, 0, 0); } while (0)
#define PG8_LDA(dst, b, h) do { _Pragma("unroll") for (int m = 0; m < 4; ++m) _Pragma("unroll") for (int k = 0; k < 2; ++k) dst[m][k] = *(const PG8_LAS bf16x8*)(lds + PG8_SA(b, h) + aoff + m * 2048 + k * 1024); } while (0)
#define PG8_LDB(dst, b, h) do { _Pragma("unroll") for (int n = 0; n < 2; ++n) _Pragma("unroll") for (int k = 0; k < 2; ++k) dst[n][k] = *(const PG8_LAS bf16x8*)(lds + PG8_SB(b, h) + boff + n * 2048 + k * 1024); } while (0)
#define PG8_MMA(ai, bj, At, Bt) do { __builtin_amdgcn_s_setprio(1); _Pragma("unroll") for (int m = 0; m < 4; ++m) _Pragma("unroll") for (int n = 0; n < 2; ++n) _Pragma("unroll") for (int k = 0; k < 2; ++k) \
        acc[ai][bj][m][n] = __builtin_amdgcn_mfma_f32_16x16x32_bf16(Bt[n][k], At[m][k], acc[ai][bj][m][n], 0, 0, 0); __builtin_amdgcn_s_setprio(0); } while (0)
#define PG8_WAIT_V(n) asm volatile("s_waitcnt vmcnt(" #n ")" ::: "memory")
#define PG8_WAIT_L(n) asm volatile("s_waitcnt lgkmcnt(" #n ")" ::: "memory")
#define PG8_BAR __builtin_amdgcn_s_barrier()
#define PG8_SCHED __builtin_amdgcn_sched_barrier(0)
    Unit cur, nxt; int ui = 0;
    if (!S.next(0, cur)) return;
    Acc acc;
#pragma unroll
    for (int a = 0; a < 2; ++a)
#pragma unroll
        for (int b = 0; b < 2; ++b)
#pragma unroll
            for (int m = 0; m < 4; ++m)
#pragma unroll
                for (int n = 0; n < 2; ++n) acc[a][b][m][n] = (f32x4){0.f, 0.f, 0.f, 0.f};
    bf16x8 At[4][2], B0[2][2], B1[2][2];
    const char* cA = (const char*)g.A + (size_t)cur.pm * g.tstepA; const char* cB = (const char*)g.Bt + (size_t)cur.pn * g.tstepB;
    PG8_STAGE(PG8_SB(0, 0), cB, voffB); PG8_STAGE(PG8_SB(0, 1), cB + hstepB, voffB); PG8_STAGE(PG8_SA(0, 0), cA, voffA); PG8_STAGE(PG8_SA(0, 1), cA + hstepA, voffA);
    if (wr == 1) PG8_BAR;
    PG8_WAIT_V(2); PG8_BAR;
    PG8_STAGE(PG8_SB(1, 0), cB + kstep, voffB); PG8_STAGE(PG8_SA(1, 0), cA + kstep, voffA); PG8_STAGE(PG8_SB(1, 1), cB + hstepB + kstep, voffB);
    PG8_WAIT_V(6); PG8_BAR;
    for (;;) {
        const bool has_next = S.next(ui + 1, nxt);
        const char* nA = has_next ? (const char*)g.A + (size_t)nxt.pm * g.tstepA : cA; const char* nB = has_next ? (const char*)g.Bt + (size_t)nxt.pn * g.tstepB : cB;
#pragma nounroll
        for (int t = 0; t < nt; t += 2) {
            const bool last = (t == nt - 2);
            const char* a1 = cA + (size_t)(t + 1) * kstep;
            const char* a2 = last ? nA : cA + (size_t)(t + 2) * kstep; const char* b2 = last ? nB : cB + (size_t)(t + 2) * kstep;
            const char* a3 = a2 + kstep; const char* b3 = b2 + kstep;
            PG8_LDB(B0, 0, 0); PG8_LDB(B1, 0, 1); PG8_SCHED; PG8_LDA(At, 0, 0); PG8_STAGE(PG8_SA(1, 1), a1 + hstepA, voffA);
            PG8_WAIT_V(8); PG8_WAIT_L(0); PG8_BAR; PG8_MMA(0, 0, At, B0); PG8_MMA(0, 1, At, B1); PG8_BAR; PG8_SCHED;
            PG8_LDA(At, 0, 1); PG8_STAGE(PG8_SB(0, 0), b2, voffB); PG8_STAGE(PG8_SB(0, 1), b2 + hstepB, voffB); PG8_STAGE(PG8_SA(0, 0), a2, voffA);
            PG8_WAIT_V(8); PG8_WAIT_L(0); PG8_BAR; PG8_MMA(1, 0, At, B0); PG8_MMA(1, 1, At, B1); PG8_BAR; PG8_SCHED;
            PG8_LDB(B0, 1, 0); PG8_LDB(B1, 1, 1); PG8_SCHED; PG8_LDA(At, 1, 0); PG8_STAGE(PG8_SA(0, 1), a2 + hstepA, voffA);
            PG8_WAIT_V(8); PG8_WAIT_L(0); PG8_BAR; PG8_MMA(0, 0, At, B0); PG8_MMA(0, 1, At, B1); PG8_BAR; PG8_SCHED;
            PG8_LDA(At, 1, 1); PG8_STAGE(PG8_SB(1, 0), b3, voffB); PG8_STAGE(PG8_SB(1, 1), b3 + hstepB, voffB); PG8_STAGE(PG8_SA(1, 0), a3, voffA);
            PG8_WAIT_V(8); PG8_WAIT_L(0); PG8_BAR; PG8_MMA(1, 0, At, B0); PG8_MMA(1, 1, At, B1); PG8_BAR; PG8_SCHED;
        }
        if constexpr (ALIGN_EPI) { if (wr == 0) PG8_BAR; }
        E(acc, cur, wr, wc, fr, fq);
        if (!has_next) break;
#pragma unroll
        for (int a = 0; a < 2; ++a)
#pragma unroll
            for (int b = 0; b < 2; ++b)
#pragma unroll
                for (int m = 0; m < 4; ++m)
#pragma unroll
                    for (int n = 0; n < 2; ++n) acc[a][b][m][n] = (f32x4){0.f, 0.f, 0.f, 0.f};
        cur = nxt; cA = nA; cB = nB; ++ui;
        if constexpr (ALIGN_EPI) { if (wr == 1) PG8_BAR; }
    }
    PG8_WAIT_V(0);
    if constexpr (!ALIGN_EPI) { if (wr == 0) PG8_BAR; }
    PG8_BAR;
#undef PG8_SA
#undef PG8_SB
#undef PG8_STAGE
#undef PG8_LDA
#undef PG8_LDB
#undef PG8_MMA
#undef PG8_WAIT_V
#undef PG8_WAIT_L
#undef PG8_BAR
#undef PG8_SCHED
}

__device__ __forceinline__ u32x4 pack8(f32x4 a, f32x4 b) { u32x4 w; w.x = cvt_pk_bf16(a[0], a[1]); w.y = cvt_pk_bf16(a[2], a[3]); w.z = cvt_pk_bf16(b[0], b[1]); w.w = cvt_pk_bf16(b[2], b[3]); return w; }

template <int ACT  > struct EpiBf16 {
    static constexpr bool PERM = true;
    bf16_t* O; int ldc; int gs;
    __device__ __forceinline__ void operator()(const Acc& acc, const Unit& u, int wr, int wc, int fr, int fq) const {
        const int row0 = u.pm * BM + wr * 64 + fr, col0 = u.pn * 2 * gs + wc * 32 + 8 * fq;
#pragma unroll
        for (int ai = 0; ai < 2; ++ai)
#pragma unroll
            for (int m = 0; m < 4; ++m) { bf16_t* rowp = O + (size_t)(row0 + ai * HALF + m * 16) * ldc + col0;
#pragma unroll
                for (int bj = 0; bj < 2; ++bj) { f32x4 v0 = acc[ai][bj][m][0], v1 = acc[ai][bj][m][1];
                    if (ACT == 1) { v0 = __builtin_elementwise_max(v0, (f32x4){0.f, 0.f, 0.f, 0.f}); v1 = __builtin_elementwise_max(v1, (f32x4){0.f, 0.f, 0.f, 0.f}); v0 = v0 * v0; v1 = v1 * v1; }
                    *(u32x4*)(rowp + bj * gs) = pack8(v0, v1); } }
    }
};
struct EpiGlu {
    static constexpr bool PERM = true;
    bf16_t* O; int ldc;
    __device__ __forceinline__ void operator()(const Acc& acc, const Unit& u, int wr, int wc, int fr, int fq) const {
        const int row0 = u.pm * BM + wr * 64 + fr, col0 = u.pn * HALF + wc * 32 + 8 * fq;
#pragma unroll
        for (int ai = 0; ai < 2; ++ai)
#pragma unroll
            for (int m = 0; m < 4; ++m) { bf16_t* rowp = O + (size_t)(row0 + ai * HALF + m * 16) * ldc + col0;
                f32x4 o[2];
#pragma unroll
                for (int n = 0; n < 2; ++n) { const f32x4 v = acc[ai][0][m][n], gt = acc[ai][1][m][n];
#pragma unroll
                    for (int j = 0; j < 4; ++j) o[n][j] = v[j] * __builtin_amdgcn_rcpf(1.0f + __expf(-gt[j])); }
                *(u32x4*)rowp = pack8(o[0], o[1]); }
    }
};
struct EpiRes {
    static constexpr bool PERM = false;
    const float* base; float* R; int ldc; float alpha;
    __device__ __forceinline__ void operator()(const Acc& acc, const Unit& u, int wr, int wc, int fr, int fq) const {
        const int row0 = u.pm * BM + wr * 64 + fr, col0 = u.pn * BM + wc * 32 + 4 * fq;
#pragma unroll
        for (int ai = 0; ai < 2; ++ai)
#pragma unroll
            for (int m = 0; m < 4; ++m) { const size_t off = (size_t)(row0 + ai * HALF + m * 16) * ldc + col0;
                f32x4 bs[2][2];
#pragma unroll
                for (int bj = 0; bj < 2; ++bj)
#pragma unroll
                    for (int n = 0; n < 2; ++n) bs[bj][n] = *(const f32x4*)(base + off + bj * HALF + n * 16);
#pragma unroll
                for (int bj = 0; bj < 2; ++bj)
#pragma unroll
                    for (int n = 0; n < 2; ++n) *(f32x4*)(R + off + bj * HALF + n * 16) = bs[bj][n] * alpha + acc[ai][bj][m][n];
                asm volatile("" ::: "memory"); }
    }
};
struct EpiF32 {
    static constexpr bool PERM = false;
    float* O; int ldc;
    __device__ __forceinline__ void operator()(const Acc& acc, const Unit& u, int wr, int wc, int fr, int fq) const {
        const int row0 = u.pm * BM + wr * 64 + fr, col0 = u.pn * BM + wc * 32 + 4 * fq;
#pragma unroll
        for (int ai = 0; ai < 2; ++ai)
#pragma unroll
            for (int m = 0; m < 4; ++m) { const size_t off = (size_t)(row0 + ai * HALF + m * 16) * ldc + col0;
#pragma unroll
                for (int bj = 0; bj < 2; ++bj)
#pragma unroll
                    for (int n = 0; n < 2; ++n) *(f32x4*)(O + off + bj * HALF + n * 16) = acc[ai][bj][m][n]; }
    }
};
struct EpiS1 {
    static constexpr bool PERM = false;
    float* E;
    __device__ __forceinline__ void operator()(const Acc& acc, const Unit& u, int wr, int wc, int fr, int fq) const {
        const int row0 = u.pm * BM + wr * 64 + fr, col0 = wc * 32 + 4 * fq;
#pragma unroll
        for (int ai = 0; ai < 2; ++ai)
#pragma unroll
            for (int m = 0; m < 4; ++m) { const size_t off = (size_t)(row0 + ai * HALF + m * 16) * 128 + col0;
#pragma unroll
                for (int n = 0; n < 2; ++n) *(f32x4*)(E + off + n * 16) = acc[ai][0][m][n]; }
    }
};
struct EpiS3 {
    static constexpr bool PERM = true;
    bf16_t* Y;
    __device__ __forceinline__ void operator()(const Acc& acc, const Unit& u, int wr, int wc, int fr, int fq) const {
        const int g = u.pm >> 2, rloc = (u.pm & 3) * BM + wr * 64 + fr;
        const int co0 = 8 * (fq & 1);
#pragma unroll
        for (int ai = 0; ai < 2; ++ai)
#pragma unroll
            for (int m = 0; m < 4; ++m) { const int r = rloc + ai * HALF + m * 16;
#pragma unroll
                for (int bj = 0; bj < 2; ++bj) { const int t = 16 * (u.pn & 1) + 8 * bj + 2 * wc + (fq >> 1);
                    f32x4 o[2];
#pragma unroll
                    for (int n = 0; n < 2; ++n)
#pragma unroll
                        for (int j = 0; j < 4; ++j) { const float v = acc[ai][bj][m][n][j]; const float z = 1.5957691216f * (v + 0.044715f * v * v * v);
                            o[n][j] = v * __builtin_amdgcn_rcpf(1.0f + __expf(-z)); }
                    *(u32x4*)(Y + ((size_t)r * 32 + t) * 1024 + g * 16 + co0) = pack8(o[0], o[1]); } }
    }
};
struct EpiQ {
    static constexpr bool PERM = true;
    bf16_t* Q; const float* CS;
    __device__ __forceinline__ void operator()(const Acc& acc, const Unit& u, int wr, int wc, int fr, int fq) const {
        const int row0 = u.pm * BM + wr * 64 + fr;
        const int h = u.pn * 4 + wc, i0 = 8 * fq;
#pragma unroll
        for (int ai = 0; ai < 2; ++ai)
#pragma unroll
            for (int m = 0; m < 4; ++m) { const int row = row0 + ai * HALF + m * 16;
                f32x4 o1[2], o2[2];
#pragma unroll
                for (int n = 0; n < 2; ++n) { const f32x4 cs = *(const f32x4*)(CS + (size_t)row * 64 + i0 + 4 * n), sn = *(const f32x4*)(CS + (size_t)row * 64 + 32 + i0 + 4 * n);
                    const f32x4 x1 = acc[ai][0][m][n], x2 = acc[ai][1][m][n];
                    o1[n] = x1 * cs - x2 * sn; o2[n] = x1 * sn + x2 * cs; }
                bf16_t* qp = Q + (size_t)row * 1536 + h * 192 + 128 + i0;
                *(u32x4*)qp = pack8(o1[0], o1[1]); *(u32x4*)(qp + 32) = pack8(o2[0], o2[1]);
                asm volatile("" ::: "memory"); }
    }
};
}

namespace att {
using bf16 = __hip_bfloat16;
typedef short bf16x8 __attribute__((ext_vector_type(8)));
typedef short s16x4 __attribute__((ext_vector_type(4)));
typedef float f32x16 __attribute__((ext_vector_type(16)));
typedef float f32x4 __attribute__((ext_vector_type(4)));
typedef unsigned u32x4 __attribute__((ext_vector_type(4)));
constexpr int NW = 8, QBLK = 32, KVBLK = 64, QB = NW * QBLK, DV = 128, DK = 192;
constexpr int SEQ = 4096, NQB = SEQ / QB;
constexpr int QS = 1536, KVS = 2048, KRS = 64, OS = 1024;
constexpr int SHM_V = KVBLK * DV * 2, SHM_K = KVBLK * DK * 2;
constexpr int NQR = 4, NQLDS = 12 - NQR, QSLOT = NQLDS * 1024;
constexpr int WS_OFF = 2 * SHM_V + 2 * SHM_K, QR_OFF = WS_OFF + NW * 64 * 4, LDS_BYTES = QR_OFF + NW * QSLOT;
constexpr float SCALE = 0.07216878364870322f;
constexpr float THR = 8.f;
#define KSWZ(row, colB) ((row) * 384 + ((colB) ^ (((row) & 7) << 4)))
#define SBAR() __builtin_amdgcn_sched_barrier(0)
__device__ __forceinline__ int v_st(int k, int c) { const int kk = (k & ~0xC) | ((k & 4) << 1) | ((k & 8) >> 1); return ((kk >> 3) * 4 + (c >> 5)) * 512 + ((kk & 7) * 32 + (c & 31)) * 2; }
__device__ __forceinline__ int v_rd_base(int lane) { return ((lane & 3) << 3) | (((lane >> 2) & 3) << 6) | (((lane >> 4) & 1) << 5) | (((lane >> 5) & 1) << 8); }
constexpr int v_rd_off(int d0, int ks, int half) { return d0 * 512 + ks * 4096 + half * 2048; }
__device__ __forceinline__ int crow(int r, int hi) { return (r & 3) + 8 * (r >> 2) + 4 * hi; }
__device__ __forceinline__ unsigned cvtpk(float lo, float hi) { unsigned r; asm volatile("v_cvt_pk_bf16_f32 %0, %1, %2" : "=v"(r) : "v"(lo), "v"(hi)); return r; }
__device__ __forceinline__ bf16x8 load8(const bf16* p) { return *reinterpret_cast<const bf16x8*>(p); }
__device__ __forceinline__ void mask_tile(f32x16& p0, f32x16& p1, int dq, unsigned W) {
    const float NEG = -__builtin_inff();
#pragma unroll
    for (int r = 0; r < 16; ++r) {
        const int c = (r & 3) + 8 * (r >> 2);
        if ((unsigned)(dq - c) >= W) p0[r] = NEG;
        if ((unsigned)(dq - c - 32) >= W) p1[r] = NEG;
    }
}
__device__ __forceinline__ void partialSM(f32x16& p0, f32x16& p1, float& m_reg, float& mn, float& alpha) {
    float pmax = p0[0]; for (int r = 1; r < 16; ++r) pmax = fmaxf(pmax, p0[r]); for (int r = 0; r < 16; ++r) pmax = fmaxf(pmax, p1[r]);
    { auto rr = __builtin_amdgcn_permlane32_swap(__float_as_uint(pmax), __float_as_uint(pmax), false, false);
      pmax = fmaxf(__uint_as_float(rr[0]), __uint_as_float(rr[1])); }
    constexpr float C2 = 1.4426950408889634f * SCALE;
    if (__builtin_expect(__all((pmax - m_reg) * SCALE <= THR), 1)) { mn = m_reg; alpha = 1.f; }
    else { mn = fmaxf(m_reg, pmax); alpha = __builtin_amdgcn_exp2f((m_reg - mn) * C2); m_reg = mn; }
    const float mnL = -mn * C2;
    for (int r = 0; r < 16; ++r) p0[r] = fmaf(p0[r], C2, mnL); for (int r = 0; r < 16; ++r) p1[r] = fmaf(p1[r], C2, mnL);
    for (int r = 0; r < 16; ++r) p0[r] = __builtin_amdgcn_exp2f(p0[r]);
}
__device__ __forceinline__ void finishSM(f32x16& p0, f32x16& p1, float alpha, float& l_reg, bf16x8& pa0, bf16x8& pa1, bf16x8& pa2, bf16x8& pa3) {
    for (int r = 0; r < 16; ++r) p1[r] = __builtin_amdgcn_exp2f(p1[r]);
    float ps = 0; for (int r = 0; r < 16; ++r) ps += p0[r]; for (int r = 0; r < 16; ++r) ps += p1[r];
    { auto rr = __builtin_amdgcn_permlane32_swap(__float_as_uint(ps), __float_as_uint(ps), false, false);
      ps = __uint_as_float(rr[0]) + __uint_as_float(rr[1]); }
    l_reg = l_reg * alpha + ps;
#define PK4(P, B_, OUT) do { unsigned a0 = cvtpk(P[B_+0], P[B_+1]), a1 = cvtpk(P[B_+2], P[B_+3]);                          \
        unsigned b0 = cvtpk(P[B_+4], P[B_+5]), b1 = cvtpk(P[B_+6], P[B_+7]);                                             \
        auto r0 = __builtin_amdgcn_permlane32_swap(a0, b0, false, false); auto r1 = __builtin_amdgcn_permlane32_swap(a1, b1, false, false); \
        u32x4 w = {r0[0], r1[0], r0[1], r1[1]}; OUT = *reinterpret_cast<bf16x8*>(&w); } while (0)
    PK4(p0, 0, pa0); PK4(p0, 8, pa1); PK4(p1, 0, pa2); PK4(p1, 8, pa3);
#undef PK4
}
template <int KB>
__device__ __forceinline__ void qkt(f32x16& p0, f32x16& p1, const char* K_lds, int r32, int hi, const bf16x8* qr, const char* qrope) {
    p0 = f32x16{}; p1 = f32x16{};
    const char* kb[4];
#pragma unroll
    for (int dd = 0; dd < 4; ++dd) kb[dd] = K_lds + KB * SHM_K + KSWZ(r32, (dd * 16 + hi * 8) * 2);
#pragma unroll
    for (int d0 = 0; d0 < NQR; ++d0) { const char* a = kb[d0 & 3] + (d0 >> 2) * 128;
        bf16x8 b0 = *reinterpret_cast<const bf16x8*>(a);
        bf16x8 b1 = *reinterpret_cast<const bf16x8*>(a + 32 * 384);
        p0 = __builtin_amdgcn_mfma_f32_32x32x16_bf16(b0, qr[d0], p0, 0, 0, 0);
        p1 = __builtin_amdgcn_mfma_f32_32x32x16_bf16(b1, qr[d0], p1, 0, 0, 0); }
#pragma unroll
    for (int d0 = NQR; d0 < 12; ++d0) { const char* a = kb[d0 & 3] + (d0 >> 2) * 128;
        bf16x8 b0 = *reinterpret_cast<const bf16x8*>(a);
        bf16x8 b1 = *reinterpret_cast<const bf16x8*>(a + 32 * 384);
        bf16x8 q = *reinterpret_cast<const bf16x8*>(qrope + (d0 - NQR) * 1024);
        p0 = __builtin_amdgcn_mfma_f32_32x32x16_bf16(b0, q, p0, 0, 0, 0);
        p1 = __builtin_amdgcn_mfma_f32_32x32x16_bf16(b1, q, p1, 0, 0, 0); }
}
template <int VB>
__device__ __forceinline__ void pv_tile(f32x16* o, int vb0, bf16x8 pa0, bf16x8 pa1, bf16x8 pa2, bf16x8 pa3) {
#define TRRD(dst, off) asm volatile("ds_read_b64_tr_b16 %0, %1 offset:%2" : "=&v"(dst) : "v"(vb0), "i"(off) : "memory")
#define PV_D0(d0) do { s16x4 l0, l1, l2, l3, h0, h1, h2, h3; constexpr int b_ = VB * SHM_V + v_rd_off(d0, 0, 0); \
        TRRD(l0, b_); TRRD(h0, b_ + 2048); TRRD(l1, b_ + 4096); TRRD(h1, b_ + 6144); TRRD(l2, b_ + 8192); TRRD(h2, b_ + 10240); TRRD(l3, b_ + 12288); TRRD(h3, b_ + 14336); \
        asm volatile("s_waitcnt lgkmcnt(0)" ::: "memory"); SBAR();   \
        o[d0] = __builtin_amdgcn_mfma_f32_32x32x16_bf16(pa0, (bf16x8){l0[0], l0[1], l0[2], l0[3], h0[0], h0[1], h0[2], h0[3]}, o[d0], 0, 0, 0);   \
        o[d0] = __builtin_amdgcn_mfma_f32_32x32x16_bf16(pa1, (bf16x8){l1[0], l1[1], l1[2], l1[3], h1[0], h1[1], h1[2], h1[3]}, o[d0], 0, 0, 0);   \
        o[d0] = __builtin_amdgcn_mfma_f32_32x32x16_bf16(pa2, (bf16x8){l2[0], l2[1], l2[2], l2[3], h2[0], h2[1], h2[2], h2[3]}, o[d0], 0, 0, 0);   \
        o[d0] = __builtin_amdgcn_mfma_f32_32x32x16_bf16(pa3, (bf16x8){l3[0], l3[1], l3[2], l3[3], h3[0], h3[1], h3[2], h3[3]}, o[d0], 0, 0, 0); } while (0)
    PV_D0(0); PV_D0(1); PV_D0(2); PV_D0(3);
#undef PV_D0
#undef TRRD
}
struct BlockRef { const bf16* Q; const bf16* K; const bf16* V; const bf16* KR; bf16* O; int P0; };
struct Seam { bf16x8 qr[NQR]; bf16x8 st_v0, st_v1, st_k0, st_k1, st_k2; };
#define ROWK(p, k0, rr) (((p) + (size_t)(k0) * KVS) + (unsigned)((rr) * KVS + sc))
#define VMW() asm volatile("s_waitcnt vmcnt(0)" ::: "memory")
#define VMWN(n) asm volatile("s_waitcnt vmcnt(%0)" :: "i"(n) : "memory")
#define SLOAD_H(Kp, Vp, KRp, k0) do { S.st_v0 = load8(ROWK(Vp, k0, sr)); S.st_v1 = load8(ROWK(Vp, k0, 32 + sr));              \
                         S.st_k0 = load8(ROWK(Kp, k0, sr)); S.st_k1 = load8(ROWK(Kp, k0, 32 + sr)); S.st_k2 = load8(((KRp) + (size_t)(k0) * KRS) + (unsigned)(rr8 * KRS + rc8)); } while (0)
#define SWRITE_HK(bf) do { *(bf16x8*)(K_lds + (bf) * SHM_K + kws) = S.st_k0; *(bf16x8*)(K_lds + (bf) * SHM_K + kws + 32 * 384) = S.st_k1; *(bf16x8*)(K_lds + (bf) * SHM_K + kws2) = S.st_k2; } while (0)
#define SWRITE_HV(bf) do { *(bf16x8*)(V_lds + (bf) * SHM_V + vst0) = S.st_v0; *(bf16x8*)(V_lds + (bf) * SHM_V + vst1) = S.st_v1; } while (0)
#define SWRITE_H(bf) do { SWRITE_HV(bf); SWRITE_HK(bf); } while (0)
__device__ __forceinline__ void attn_prime(const BlockRef& cur, char* lds, Seam& S) {
    int tid_ = threadIdx.x; asm volatile("" : "+v"(tid_));
    const int tid = tid_, wid = __builtin_amdgcn_readfirstlane(tid >> 6), lane = tid & 63, r32 = lane & 31, hi = lane >> 5;
    const int sr = tid >> 4, sc = (tid & 15) * 8, kws = KSWZ(sr, sc * 2), rr8 = tid >> 3, rc8 = (tid & 7) * 8, kws2 = KSWZ(rr8, (128 + rc8) * 2); char* K_lds = lds + 2 * SHM_V;
    char* qrope = lds + QR_OFF + wid * QSLOT + lane * 16;
    const bf16* qrow = cur.Q + (size_t)(wid * QBLK + r32) * QS + hi * 8;
#pragma unroll
    for (int d0 = 0; d0 < NQR; ++d0) S.qr[d0] = load8(qrow + d0 * 16);
#pragma unroll
    for (int d0 = NQR; d0 < 12; ++d0) *(bf16x8*)(qrope + (d0 - NQR) * 1024) = load8(qrow + d0 * 16);
    SLOAD_H(cur.K, cur.V, cur.KR, 0); VMW(); SWRITE_HK(0);
    __syncthreads();
}
__device__ __forceinline__ void attn_block(const BlockRef& cur, const BlockRef& nxt, char* lds, Seam& S) {
    int tid_ = threadIdx.x; asm volatile("" : "+v"(tid_));
    const int tid = tid_, wid = __builtin_amdgcn_readfirstlane(tid >> 6), lane = tid & 63, r32 = lane & 31, hi = lane >> 5;
    constexpr int W = SEQ;
    const int NT = (cur.P0 + QB - 1) / KVBLK + 1;
    const int qlo = cur.P0 + wid * QBLK, qm = qlo + r32 - 4 * hi;
    char* V_lds = lds; char* K_lds = lds + 2 * SHM_V;
    float* ws = (float*)(lds + WS_OFF) + wid * 64; float* li_l = ws, * al_l = ws + 32;
    char* qrope = lds + QR_OFF + wid * QSLOT + lane * 16;
    float m_reg = -1e30f, l_reg = 0; f32x16 o[4] = {};
    const int sr = tid >> 4, sc = (tid & 15) * 8, vst0 = v_st(sr, sc), vst1 = v_st(32 + sr, sc), kws = KSWZ(sr, sc * 2);
    const int rr8 = tid >> 3, rc8 = (tid & 7) * 8, kws2 = KSWZ(rr8, (128 + rc8) * 2);
    const int vb0 = (int)(uintptr_t)V_lds + v_rd_base(lane);
    const bf16* Kh = cur.K; const bf16* Vh = cur.V; const bf16* KRh = cur.KR;
#define RESC(a) do { if (__any((a) < 1.f)) { if (hi == 0) al_l[r32] = (a); asm volatile("s_waitcnt lgkmcnt(0)" ::: "memory");              \
                     for (int d_ = 0; d_ < 4; ++d_) for (int r = 0; r < 16; ++r) o[d_][r] *= al_l[crow(r, hi)]; } } while (0)
#define KBASE(t) ((t) * KVBLK)
#define MASKT(P0_, P1_, t) do { const int kb_ = KBASE(t); if (kb_ + KVBLK - 1 > qlo) mask_tile(P0_, P1_, qm - kb_, (unsigned)W); } while (0)
    constexpr int NQL = NQR;
#define SEAM_K0() do { VMWN(NQL); SWRITE_HK(0); SBAR(); } while (0)
    f32x16 pA0, pA1, pB0, pB1; float mnA, mnB, alA, alB; bf16x8 pa0, pa1, pa2, pa3;
    SWRITE_HV(0); SBAR();
    if (NT > 1) { SLOAD_H(Kh, Vh, KRh, KBASE(1)); }
    SBAR(); qkt<0>(pA0, pA1, K_lds, r32, hi, S.qr, qrope);
    MASKT(pA0, pA1, 0); partialSM(pA0, pA1, m_reg, mnA, alA);
    if (NT > 1) { VMW(); SWRITE_H(1); }
    __syncthreads();
#define HALF_STEP(PX0, PX1, mnX, alX, PY0, PY1, alY, t, KB, VB, SB) do {                                                      \
        SBAR(); qkt<KB>(PX0, PX1, K_lds, r32, hi, S.qr, qrope);                                                               \
        finishSM(PY0, PY1, alY, l_reg, pa0, pa1, pa2, pa3); SBAR();                                                           \
        if ((t) + 1 < NT) { SLOAD_H(Kh, Vh, KRh, KBASE((t) + 1)); SBAR(); }                                                   \
        pv_tile<VB>(o, vb0, pa0, pa1, pa2, pa3); MASKT(PX0, PX1, (t)); partialSM(PX0, PX1, m_reg, mnX, alX);                  \
        __syncthreads();                                                                                                      \
        if ((t) + 1 < NT) { VMW(); SWRITE_H(SB); }                                                                            \
        RESC(alX); __syncthreads(); } while (0)
    for (int t = 1; t + 1 < NT; t += 2) {
        HALF_STEP(pB0, pB1, mnB, alB, pA0, pA1, alA, t, 1, 0, 0);
        HALF_STEP(pA0, pA1, mnA, alA, pB0, pB1, alB, t + 1, 0, 1, 1);
    }
    const bool even = (NT & 1) == 0;
    if (even) { SBAR(); qkt<1>(pB0, pB1, K_lds, r32, hi, S.qr, qrope); SBAR(); }
    SLOAD_H(nxt.K, nxt.V, nxt.KR, 0); SBAR();
    const bf16* nqrow = nxt.Q + (size_t)(wid * QBLK + r32) * QS + hi * 8;
#pragma unroll
    for (int d0 = 0; d0 < NQR; ++d0) S.qr[d0] = load8(nqrow + d0 * 16);
    SBAR();
    finishSM(pA0, pA1, alA, l_reg, pa0, pa1, pa2, pa3); SBAR();
    pv_tile<0>(o, vb0, pa0, pa1, pa2, pa3);
    if (even) { MASKT(pB0, pB1, NT - 1); partialSM(pB0, pB1, m_reg, mnB, alB); __syncthreads(); RESC(alB);
        finishSM(pB0, pB1, alB, l_reg, pa0, pa1, pa2, pa3); SBAR(); pv_tile<1>(o, vb0, pa0, pa1, pa2, pa3); }
    SBAR(); SEAM_K0();
    if (hi == 0) li_l[r32] = l_reg; asm volatile("s_waitcnt lgkmcnt(0)" ::: "memory");
    float rli[16];
#pragma unroll
    for (int r = 0; r < 16; ++r) rli[r] = __builtin_amdgcn_rcpf(li_l[crow(r, hi)]);
    bf16* Ow = cur.O + (size_t)(wid * QBLK) * OS;
#pragma unroll
    for (int r = 0; r < 16; ++r) { const int orow = crow(r, hi);
#pragma unroll
        for (int d0 = 0; d0 < 4; ++d0) { const float v = o[d0][r] * rli[r];
            const float vn = __shfl_xor(v, 1);
            if ((r32 & 1) == 0) *(unsigned*)(Ow + (size_t)orow * OS + d0 * 32 + r32) = cvtpk(v, vn); } }
#pragma unroll
    for (int d0 = NQR; d0 < 12; ++d0) *(bf16x8*)(qrope + (d0 - NQR) * 1024) = load8(nqrow + d0 * 16);
    __syncthreads();
#undef RESC
#undef KBASE
#undef MASKT
#undef SEAM_K0
#undef HALF_STEP
}
#undef ROWK
#undef VMW
#undef VMWN
#undef SLOAD_H
#undef SWRITE_HK
#undef SWRITE_HV
#undef SWRITE_H
struct Tensors { const bf16* Q; const bf16* KV; const bf16* KR; bf16* O; };
__device__ __forceinline__ BlockRef mk_ref(const Tensors& T, int bh, int qb) {
    const int b = bh >> 3, h = bh & 7; BlockRef r;
    r.Q = T.Q + ((size_t)b * SEQ + (size_t)qb * QB) * QS + h * DK;
    r.K = T.KV + (size_t)b * SEQ * KVS + h * 256; r.V = r.K + 128;
    r.KR = T.KR + (size_t)b * SEQ * KRS;
    r.O = T.O + ((size_t)b * SEQ + (size_t)qb * QB) * OS + h * DV; r.P0 = qb * QB;
    return r;
}
__device__ __forceinline__ void attn_phase(char* lds, const Tensors& T, int G, int vcu) {
    constexpr int NX = NQB / 2, TOTAL = 64 * NX;
    int L = vcu; if (L >= TOTAL) return;
    int bh = L / NX, x = L % NX, pass = 0;
    BlockRef cur = mk_ref(T, bh, x);
    Seam S;
    attn_prime(cur, lds, S);
    for (;;) {
        const bool more_pass = pass == 0, more_item = L + G < TOTAL, last = !more_pass && !more_item;
        int bhn = bh, xn = x, passn = pass + 1, Ln = L;
        if (!more_pass) { passn = 0; Ln = more_item ? L + G : L; bhn = Ln / NX; xn = Ln % NX; }
        const BlockRef nxt = last ? cur : mk_ref(T, bhn, passn ? NQB - 1 - xn : xn);
        attn_block(cur, nxt, lds, S);
        if (last) break;
        cur = nxt; bh = bhn; x = xn; pass = passn; L = Ln;
    }
}
}

constexpr int NWAVES = 8;
constexpr int BATCH = 8, SEQ = 4096, D = 1024, FF = 4096, M = BATCH * SEQ;
constexpr int NG = 64, NP = 64, CH = 32, NCH = SEQ / CH, XG_LD = 640, RPG = BATCH * NCH;
constexpr float LN_EPS = 1e-5f, RMS_EPS = 1e-6f, DN_ALPHA = 1.4142135623730951f;
constexpr size_t MiB = 1u << 20;
constexpr size_t WS_WGLU = 1 * MiB, WS_WOUT = 5 * MiB, WS_W1 = 7 * MiB, WS_W2 = 23 * MiB, WS_WQKVA = 39 * MiB, WS_WKVB = 41 * MiB, WS_WQB = 42 * MiB, WS_WO = 44 * MiB;
constexpr size_t WS_W1G = 46 * MiB, WS_TG = 55 * MiB, WS_KBUF = 95 * MiB, WS_AL = 97 * MiB, WS_XG = 98 * MiB, WS_E = 178 * MiB, WS_YACT = 210 * MiB, WS_G = 274 * MiB;
constexpr size_t WS_HB = 400 * MiB, WS_HID = 98 * MiB;
constexpr size_t WS_CQKV = 98 * MiB, WS_CKV = 194 * MiB, WS_CQ = 210 * MiB, WS_KR = 234 * MiB, WS_CS = 238 * MiB, WS_KV = 246 * MiB, WS_Q = 374 * MiB, WS_O = 98 * MiB;
constexpr size_t WS_END = 470 * MiB;
constexpr int LDS_BYTES = 153600;

#define GAS __attribute__((address_space(1)))
#define LAS __attribute__((address_space(3)))
typedef unsigned short bf16;
typedef unsigned v4u __attribute__((ext_vector_type(4)));
typedef unsigned v2u __attribute__((ext_vector_type(2)));
typedef float f32x4 __attribute__((ext_vector_type(4)));
typedef float f32x2 __attribute__((ext_vector_type(2)));
#define LDS_WAIT() asm volatile("s_waitcnt lgkmcnt(0)" ::: "memory")
__device__ __forceinline__ unsigned f2bf(float f) { unsigned u = __builtin_bit_cast(unsigned, f); return (u + 0x7fffu + ((u >> 16) & 1u)) >> 16; }
__device__ __forceinline__ unsigned pk2(float lo, float hi) { return f2bf(lo) | (f2bf(hi) << 16); }
__device__ __forceinline__ float wave_sum(float v) {
#pragma unroll
    for (int o = 1; o < 64; o <<= 1) v += __shfl_xor(v, o);
    return v;
}
__device__ __forceinline__ void sincos_red(float ang, float& s, float& c) {
    const float n = rintf(ang * 0.15915494309189535f);
    float r = fmaf(-n, 6.2831854820251465f, ang); r = fmaf(-n, -1.7484556e-7f, r);
    s = sinf(r); c = cosf(r);
}
__device__ __forceinline__ void cpow_a(float lrdt, float lidt, float k, float& re, float& im) {
    const float mag = expf(k * lrdt); float s, c; sincos_red(k * lidt, s, c); re = mag * c; im = mag * s;
}

struct Args { const void* in[25]; float* out; unsigned char* ws; };
__device__ __forceinline__ int launder(int v) { asm volatile("" : "+v"(v)); return v; }

__device__ __forceinline__ int map_row(int mode, int n0) {
    if (mode == 0) return n0;
    if (mode == 1) { const int gate = n0 >= 1024, c = gate ? n0 - 1024 : n0; return 256 * (c >> 7) + (gate ? 128 : 0) + (c & 127); }
    const int h = n0 / 192, d = n0 % 192;
    if (d < 128) return h * 128 + d;
    const int half = d >= 160, i = d - 128 - 32 * half;
    return 1024 + (h >> 2) * 256 + half * 128 + (h & 3) * 32 + i;
}
__device__ __forceinline__ void transpose_item(const float* W, int K, int N, bf16* WT, int row_off, int mode, LAS float* scr, int item, int lane) {
    const int nblk = N / 32, kb = item / nblk, nb = item % nblk, k0 = 64 * kb, n0 = 32 * nb;
#pragma unroll 8
    for (int i = 0; i < 32; ++i) { const int kk = 2 * i + (lane >> 5); scr[kk * 33 + (lane & 31)] = W[(size_t)(k0 + kk) * N + n0 + (lane & 31)]; }
    LDS_WAIT(); asm volatile("" ::: "memory");
    const int c = lane & 7, r0 = row_off + map_row(mode, n0);
#pragma unroll
    for (int j = 0; j < 4; ++j) { const int n = (lane >> 3) + 8 * j; const LAS float* s = scr + (8 * c) * 33 + n;
        v4u o; o.x = pk2(s[0 * 33], s[1 * 33]); o.y = pk2(s[2 * 33], s[3 * 33]); o.z = pk2(s[4 * 33], s[5 * 33]); o.w = pk2(s[6 * 33], s[7 * 33]);
        *(v4u*)(WT + (size_t)(r0 + n) * K + k0 + 8 * c) = o; }
    LDS_WAIT(); asm volatile("" ::: "memory");
}
__device__ __forceinline__ void ln_row(float* row, bf16* orow, const float* g, const float* b, int lane) {
    f32x4* xr = (f32x4*)row + lane;
    f32x4 v[4]; float s = 0.f;
#pragma unroll
    for (int j = 0; j < 4; ++j) { v[j] = xr[64 * j]; s += (v[j].x + v[j].y) + (v[j].z + v[j].w); }
    const float mean = wave_sum(s) * (1.f / D); float s2 = 0.f;
#pragma unroll
    for (int j = 0; j < 4; ++j) { v[j] = v[j] - mean; s2 += (v[j].x * v[j].x + v[j].y * v[j].y) + (v[j].z * v[j].z + v[j].w * v[j].w); }
    const float rstd = 1.f / sqrtf(wave_sum(s2) * (1.f / D) + LN_EPS);
#pragma unroll
    for (int j = 0; j < 4; ++j) { const f32x4 gg = *((const f32x4*)g + lane + 64 * j), bb = *((const f32x4*)b + lane + 64 * j);
        const f32x4 y = v[j] * rstd * gg + bb; xr[64 * j] = y;
        if (orow) { v2u w; w.x = pk2(y.x, y.y); w.y = pk2(y.z, y.w); *((v2u*)orow + lane + 64 * j) = w; } }
}

__global__ void __launch_bounds__(NWAVES * 64, 2) mega_fwd(Args args) {
    extern __shared__ __attribute__((aligned(16))) unsigned char lds[];
    cg::grid_group grid = cg::this_grid();
    LAS unsigned char* ldsl = (LAS unsigned char*)lds;
    const int tid = threadIdx.x, lane0 = tid & 63, wave = __builtin_amdgcn_readfirstlane(tid >> 6);
    const int G = gridDim.x, bx = blockIdx.x;
    const int vcu = (G % 8 == 0) ? (bx % 8) * (G / 8) + bx / 8 : bx;
    const int gw = vcu * NWAVES + wave, NGW = G * NWAVES;
    unsigned char* ws = args.ws;
    const float* x = (const float*)args.in[0]; const int* positions = (const int*)args.in[1];
    const float* ln_mix_g = (const float*)args.in[2]; const float* ln_mix_b = (const float*)args.in[3];
    const float* ln_ffn_g = (const float*)args.in[4]; const float* ln_ffn_b = (const float*)args.in[5];
    const float* w_ff1 = (const float*)args.in[6]; const float* w_ff2 = (const float*)args.in[7];
    const float* lam_re = (const float*)args.in[8]; const float* lam_im = (const float*)args.in[9]; const float* log_dt = (const float*)args.in[10];
    const float* b_re = (const float*)args.in[11]; const float* b_im = (const float*)args.in[12]; const float* c_re = (const float*)args.in[13]; const float* c_im = (const float*)args.in[14];
    const float* ssm_d = (const float*)args.in[15]; const float* w_glu = (const float*)args.in[16]; const float* w_out = (const float*)args.in[17];
    const float* kv_w_a = (const float*)args.in[18]; const float* kv_norm_g = (const float*)args.in[19]; const float* kv_w_b = (const float*)args.in[20];
    const float* q_w_a = (const float*)args.in[21]; const float* q_norm_g = (const float*)args.in[22]; const float* q_w_b = (const float*)args.in[23]; const float* attn_w_o = (const float*)args.in[24];
    float* R = args.out;
    bf16* Wglu_t = (bf16*)(ws + WS_WGLU); bf16* Wout_t = (bf16*)(ws + WS_WOUT); bf16* W1_t = (bf16*)(ws + WS_W1); bf16* W2_t = (bf16*)(ws + WS_W2);
    bf16* Wqkva_t = (bf16*)(ws + WS_WQKVA); bf16* Wkvb_t = (bf16*)(ws + WS_WKVB); bf16* Wqb_t = (bf16*)(ws + WS_WQB); bf16* Wo_t = (bf16*)(ws + WS_WO);
    bf16* W1g = (bf16*)(ws + WS_W1G); bf16* Tg = (bf16*)(ws + WS_TG); float* Kbuf = (float*)(ws + WS_KBUF); float* AL = (float*)(ws + WS_AL);
    bf16* Xg = (bf16*)(ws + WS_XG); float* Ebuf = (float*)(ws + WS_E); bf16* Yact = (bf16*)(ws + WS_YACT); bf16* Gb = (bf16*)(ws + WS_G);
    bf16* Hb = (bf16*)(ws + WS_HB); bf16* HID = (bf16*)(ws + WS_HID);
    float* CQKV = (float*)(ws + WS_CQKV); bf16* CKV = (bf16*)(ws + WS_CKV); bf16* CQ = (bf16*)(ws + WS_CQ); bf16* KR = (bf16*)(ws + WS_KR); float* CS = (float*)(ws + WS_CS);
    bf16* KV = (bf16*)(ws + WS_KV); bf16* Qb = (bf16*)(ws + WS_Q); bf16* Ob = (bf16*)(ws + WS_O);

    {
        const int lane = launder(lane0);
        LAS float* scr = (LAS float*)(ldsl + wave * 16384);
        constexpr int I_GLU = 16 * 64, I_OUT = 16 * 32, I_F1 = 16 * 128, I_F2 = 64 * 32, I_KVA = 16 * 10, I_QA = 16 * 12, I_KVB = 4 * 64, I_QB = 6 * 48, I_WO = 16 * 32;
        constexpr int NT_ITEMS = I_GLU + I_OUT + 2 * I_F1 + 2 * I_F2 + I_KVA + I_QA + I_KVB + I_QB + I_WO;
        for (int it = gw; it < NT_ITEMS; it += NGW) {
            int r = it;
            if (r < I_GLU) { transpose_item(w_glu, 1024, 2048, Wglu_t, 0, 1, scr, r, lane); continue; } r -= I_GLU;
            if (r < I_OUT) { transpose_item(w_out, 1024, 1024, Wout_t, 0, 0, scr, r, lane); continue; } r -= I_OUT;
            if (r < I_F1) { transpose_item(w_ff1, 1024, 4096, W1_t, 0, 0, scr, r, lane); continue; } r -= I_F1;
            if (r < I_F1) { transpose_item(w_ff1 + (size_t)1024 * 4096, 1024, 4096, W1_t + (size_t)4096 * 1024, 0, 0, scr, r, lane); continue; } r -= I_F1;
            if (r < I_F2) { transpose_item(w_ff2, 4096, 1024, W2_t, 0, 0, scr, r, lane); continue; } r -= I_F2;
            if (r < I_F2) { transpose_item(w_ff2 + (size_t)4096 * 1024, 4096, 1024, W2_t + (size_t)1024 * 4096, 0, 0, scr, r, lane); continue; } r -= I_F2;
            if (r < I_KVA) { transpose_item(kv_w_a, 1024, 320, Wqkva_t, 0, 0, scr, r, lane); continue; } r -= I_KVA;
            if (r < I_QA) { transpose_item(q_w_a, 1024, 384, Wqkva_t, 320, 0, scr, r, lane); continue; } r -= I_QA;
            if (r < I_KVB) { transpose_item(kv_w_b, 256, 2048, Wkvb_t, 0, 0, scr, r, lane); continue; } r -= I_KVB;
            if (r < I_QB) { transpose_item(q_w_b, 384, 1536, Wqb_t, 0, 2, scr, r, lane); continue; } r -= I_QB;
            transpose_item(attn_w_o, 1024, 1024, Wo_t, 0, 0, scr, r, lane);
        }
        for (int i = gw * 64 + lane; i < 8192; i += NGW * 64) { *((v4u*)(Wqkva_t + (size_t)704 * 1024) + i) = (v4u){0u, 0u, 0u, 0u}; *((v4u*)(W1g + (size_t)NG * 128 * 512) + i) = (v4u){0u, 0u, 0u, 0u}; }
        for (int it = gw; it < 4096 + 2048 + 2048 + 64; it += NGW) {
            if (it < 4096) {
                const int g = it >> 6, p = it & 63;
                const float lr = lam_re[g * 64 + p], li = lam_im[g * 64 + p], dt = expf(log_dt[g]), lrdt = lr * dt, lidt = li * dt;
                float are, aim; cpow_a(lrdt, lidt, 1.f, are, aim);
                const float inv = 1.0f / (lr * lr + li * li), cre = ((are - 1.0f) * lr + aim * li) * inv, cim = (aim * lr - (are - 1.0f) * li) * inv;
                const int c = lane & 15;
                const float br = b_re[(size_t)(g * 64 + p) * 16 + c], bi = b_im[(size_t)(g * 64 + p) * 16 + c];
                const float bbre = cre * br - cim * bi, bbim = cre * bi + cim * br;
#pragma unroll
                for (int i = 0; i < 8; ++i) { const int s = (lane >> 4) + 4 * i; float pr, pi; cpow_a(lrdt, lidt, (float)(31 - s), pr, pi);
                    W1g[(size_t)(g * 128 + p) * 512 + s * 16 + c] = (bf16)f2bf(pr * bbre - pi * bbim);
                    W1g[(size_t)(g * 128 + 64 + p) * 512 + s * 16 + c] = (bf16)f2bf(pr * bbim + pi * bbre); }
            } else if (it < 4096 + 2048) {
                const int r = it - 4096, g = r >> 5, j = r & 31;
                LAS float* sbr = scr; LAS float* sbi = scr + 1024; LAS float* scre = scr + 2048; LAS float* scim = scr + 3072;
#pragma unroll
                for (int q = 0; q < 4; ++q) { const int idx = (q * 64 + lane) * 4;
                    *(LAS f32x4*)(sbr + idx) = *(const f32x4*)(b_re + (size_t)g * 1024 + idx); *(LAS f32x4*)(sbi + idx) = *(const f32x4*)(b_im + (size_t)g * 1024 + idx);
                    *(LAS f32x4*)(scre + idx) = *(const f32x4*)(c_re + (size_t)g * 1024 + idx); *(LAS f32x4*)(scim + idx) = *(const f32x4*)(c_im + (size_t)g * 1024 + idx); }
                const int p = lane;
                const float lr = lam_re[g * 64 + p], li = lam_im[g * 64 + p], dt = expf(log_dt[g]), lrdt = lr * dt, lidt = li * dt;
                float are, aim; cpow_a(lrdt, lidt, 1.f, are, aim);
                const float inv = 1.0f / (lr * lr + li * li), cre = ((are - 1.0f) * lr + aim * li) * inv, cim = (aim * lr - (are - 1.0f) * li) * inv;
                float pr, pi; cpow_a(lrdt, lidt, (float)j, pr, pi);
                const float zre = pr * cre - pi * cim, zim = pr * cim + pi * cre;
                LDS_WAIT(); asm volatile("" ::: "memory");
                const int ci = lane & 15, cog = lane >> 4;
                float acc4[4] = {0.f, 0.f, 0.f, 0.f};
                for (int pp = 0; pp < 64; ++pp) {
                    const float zr = __shfl(zre, pp), zi = __shfl(zim, pp), br = sbr[pp * 16 + ci], bi = sbi[pp * 16 + ci];
                    const float xr = zr * br - zi * bi, xi = zr * bi + zi * br;
#pragma unroll
                    for (int k = 0; k < 4; ++k) acc4[k] += scre[(cog + 4 * k) * 64 + pp] * xr - scim[(cog + 4 * k) * 64 + pp] * xi;
                }
#pragma unroll
                for (int k = 0; k < 4; ++k) { const int co = cog + 4 * k; float v = acc4[k]; if (j == 0 && co == ci) v += ssm_d[g * 16 + co];
                    Kbuf[((size_t)(g * 32 + j) * 16 + co) * 16 + ci] = v; }
                LDS_WAIT(); asm volatile("" ::: "memory");
            } else if (it < 4096 + 4096) {
                const int r = it - 6144, g = r >> 5, t = r & 31, p = lane;
                const float lr = lam_re[g * 64 + p], li = lam_im[g * 64 + p], dt = expf(log_dt[g]);
                float pr, pi; cpow_a(lr * dt, li * dt, (float)(t + 1), pr, pi);
#pragma unroll 4
                for (int co = 0; co < 16; ++co) { const float cr = c_re[(size_t)(g * 16 + co) * 64 + p], cim_ = c_im[(size_t)(g * 16 + co) * 64 + p];
                    bf16* rowp = Tg + (size_t)(g * 512 + t * 16 + co) * XG_LD + 512;
                    rowp[p] = (bf16)f2bf(cr * pr - cim_ * pi); rowp[64 + p] = (bf16)f2bf(-(cr * pi + cim_ * pr)); }
            } else {
                const int g = it - 8192, p = lane;
                const float lr = lam_re[g * 64 + p], li = lam_im[g * 64 + p], dt = expf(log_dt[g]);
                float pr, pi; cpow_a(lr * dt, li * dt, 32.f, pr, pi);
                AL[(g * 64 + p) * 2] = pr; AL[(g * 64 + p) * 2 + 1] = pi;
            }
        }
        for (int tok = gw; tok < M; tok += NGW) {
            const f32x4* src = (const f32x4*)(x + (size_t)tok * D + lane * 16);
            const f32x4 v0 = src[0], v1 = src[1], v2 = src[2], v3 = src[3];
            v4u o0, o1; o0.x = pk2(v0.x, v0.y); o0.y = pk2(v0.z, v0.w); o0.z = pk2(v1.x, v1.y); o0.w = pk2(v1.z, v1.w);
            o1.x = pk2(v2.x, v2.y); o1.y = pk2(v2.z, v2.w); o1.z = pk2(v3.x, v3.y); o1.w = pk2(v3.z, v3.w);
            v4u* dst = (v4u*)(Xg + ((size_t)lane * RPG + (tok >> 5)) * XG_LD + (tok & 31) * 16);
            dst[0] = o0; dst[1] = o1;
        }
    }
    grid.sync();
    {
        pg8::Gemm g{Xg, W1g, 512, XG_LD, 512, (unsigned)(256 * XG_LD * 2), (unsigned)(128 * 512 * 2)};
        pg8::BatchOrder S; S.init(NG, 4, 1, G, bx);
        pg8::EpiS1 E{Ebuf};
        pg8::gemm_phase<pg8::EpiS1, pg8::BatchOrder, true>(ldsl, g, S, E);
        const int lane = launder(lane0);
        for (int it = gw; it < 2048; it += NGW) {
            const int g_ = it >> 5, t = it & 31, ci = lane & 15;
            for (int co = 0; co < 16; ++co) {
                bf16* rowp = Tg + (size_t)(g_ * 512 + t * 16 + co) * XG_LD;
#pragma unroll
                for (int i = 0; i < 8; ++i) { const int s = (lane >> 4) + 4 * i;
                    const float v = s <= t ? Kbuf[((size_t)(g_ * 32 + (t - s)) * 16 + co) * 16 + ci] : 0.f;
                    rowp[s * 16 + ci] = (bf16)f2bf(v); }
            }
        }
    }
    grid.sync();
    if (wave < 2) {
        const int item = bx * 2 + wave;
        if (item < NG * BATCH) {
            const int g_ = item >> 3, b = item & 7, p = launder(lane0);
            const float ar = AL[(g_ * 64 + p) * 2], ai = AL[(g_ * 64 + p) * 2 + 1];
            float hr = 0.f, hi = 0.f;
            const float* Ep = Ebuf + ((size_t)g_ * RPG + b * NCH) * 128 + p;
            bf16* Hp = Xg + ((size_t)g_ * RPG + b * NCH) * XG_LD + 512 + p;
            for (int c0 = 0; c0 < NCH; c0 += 8) {
                float er[8], ei[8];
#pragma unroll
                for (int k = 0; k < 8; ++k) { er[k] = Ep[(size_t)(c0 + k) * 128]; ei[k] = Ep[(size_t)(c0 + k) * 128 + 64]; }
#pragma unroll
                for (int k = 0; k < 8; ++k) { Hp[(size_t)(c0 + k) * XG_LD] = (bf16)f2bf(hr); Hp[(size_t)(c0 + k) * XG_LD + 64] = (bf16)f2bf(hi);
                    const float nr = ar * hr - ai * hi + er[k], ni = ar * hi + ai * hr + ei[k]; hr = nr; hi = ni; }
            }
        }
    }
    grid.sync();
    {
        pg8::Gemm g{Xg, Tg, XG_LD, XG_LD, XG_LD, (unsigned)(256 * XG_LD * 2), (unsigned)(256 * XG_LD * 2)};
        pg8::BatchOrder S; S.init(NG, 4, 2, G, bx);
        pg8::EpiS3 E{Yact};
        pg8::gemm_phase<pg8::EpiS3, pg8::BatchOrder, true>(ldsl, g, S, E);
    }
    grid.sync();
    {
        pg8::Gemm g{Yact, Wglu_t, 1024, 1024, 1024, (unsigned)(256 * 1024 * 2), (unsigned)(256 * 1024 * 2)};
        pg8::StaticOrder S; S.init(M, 2048, G, bx);
        pg8::EpiGlu E{Gb, 1024};
        pg8::gemm_phase<pg8::EpiGlu, pg8::StaticOrder, true>(ldsl, g, S, E);
    }
    grid.sync();
    {
        pg8::Gemm g{Gb, Wout_t, 1024, 1024, 1024, (unsigned)(256 * 1024 * 2), (unsigned)(256 * 1024 * 2)};
        pg8::StaticOrder S; S.init(M, 1024, G, bx);
        pg8::EpiRes E{x, R, 1024, DN_ALPHA};
        pg8::gemm_phase<pg8::EpiRes, pg8::StaticOrder, true>(ldsl, g, S, E);
    }
    grid.sync();
#pragma unroll
    for (int layer = 0; layer < 2; ++layer) {
        if (layer == 1) {
            {
                pg8::Gemm g{Hb, Wqkva_t, 1024, 1024, 1024, (unsigned)(256 * 1024 * 2), (unsigned)(256 * 1024 * 2)};
                pg8::StaticOrder S; S.init(M, 768, G, bx);
                pg8::EpiF32 E{CQKV, 768};
                pg8::gemm_phase<pg8::EpiF32, pg8::StaticOrder, true>(ldsl, g, S, E);
            }
            grid.sync();
            const int lane = launder(lane0);
            for (int tok = gw; tok < M; tok += NGW) {
                const float* row = CQKV + (size_t)tok * 768;
                const f32x4 kv = *((const f32x4*)row + lane);
                const f32x2 q0 = *((const f32x2*)(row + 320) + lane * 3), q1 = *((const f32x2*)(row + 320) + lane * 3 + 1), q2 = *((const f32x2*)(row + 320) + lane * 3 + 2);
                const float skv = wave_sum(kv.x * kv.x + kv.y * kv.y + kv.z * kv.z + kv.w * kv.w);
                const float sq = wave_sum(q0.x * q0.x + q0.y * q0.y + q1.x * q1.x + q1.y * q1.y + q2.x * q2.x + q2.y * q2.y);
                const float rkv = 1.0f / sqrtf(skv * (1.0f / 256.0f) + RMS_EPS), rq = 1.0f / sqrtf(sq * (1.0f / 384.0f) + RMS_EPS);
                const f32x4 gk = *((const f32x4*)kv_norm_g + lane);
                v2u wkv; wkv.x = pk2(kv.x * rkv * gk.x, kv.y * rkv * gk.y); wkv.y = pk2(kv.z * rkv * gk.z, kv.w * rkv * gk.w);
                *((v2u*)(CKV + (size_t)tok * 256) + lane) = wkv;
                const float* gq = q_norm_g + lane * 6;
                unsigned* qo = (unsigned*)(CQ + (size_t)tok * 384) + lane * 3;
                qo[0] = pk2(q0.x * rq * gq[0], q0.y * rq * gq[1]); qo[1] = pk2(q1.x * rq * gq[2], q1.y * rq * gq[3]); qo[2] = pk2(q2.x * rq * gq[4], q2.y * rq * gq[5]);
                if (lane < 32) {
                    const float pos = (float)positions[tok];
                    const float invf = exp2f(-(float)lane * (13.287712379549449f / 32.0f));
                    float sn, cs; sincos_red(pos * invf, sn, cs);
                    CS[(size_t)tok * 64 + lane] = cs; CS[(size_t)tok * 64 + 32 + lane] = sn;
                    const float x1 = row[256 + lane], x2 = row[288 + lane];
                    KR[(size_t)tok * 64 + lane] = (bf16)f2bf(x1 * cs - x2 * sn); KR[(size_t)tok * 64 + 32 + lane] = (bf16)f2bf(x1 * sn + x2 * cs);
                }
            }
            grid.sync();
            {
                pg8::Gemm g{CKV, Wkvb_t, 256, 256, 256, (unsigned)(256 * 256 * 2), (unsigned)(256 * 256 * 2)};
                pg8::StaticOrder S; S.init(M, 2048, G, bx);
                pg8::EpiBf16<0> E{KV, 2048, 128};
                pg8::gemm_phase<pg8::EpiBf16<0>, pg8::StaticOrder, true>(ldsl, g, S, E);
            }
            {
                pg8::Gemm g{CQ, Wqb_t, 384, 384, 384, (unsigned)(256 * 384 * 2), (unsigned)(256 * 384 * 2)};
                pg8::StaticOrder S; S.init(M, 1024, G, bx);
                pg8::EpiBf16<0> E{Qb, 1536, 192};
                pg8::gemm_phase<pg8::EpiBf16<0>, pg8::StaticOrder, true>(ldsl, g, S, E);
            }
            {
                pg8::Gemm g{CQ, Wqb_t + (size_t)1024 * 384, 384, 384, 384, (unsigned)(256 * 384 * 2), (unsigned)(256 * 384 * 2)};
                pg8::StaticOrder S; S.init(M, 512, G, bx);
                pg8::EpiQ E{Qb, CS};
                pg8::gemm_phase<pg8::EpiQ, pg8::StaticOrder, true>(ldsl, g, S, E);
            }
            grid.sync();
            {
                const att::Tensors T{(const att::bf16*)Qb, (const att::bf16*)KV, (const att::bf16*)KR, (att::bf16*)Ob};
                att::attn_phase((char*)lds, T, G, vcu);
            }
            grid.sync();
            {
                pg8::Gemm g{Ob, Wo_t, 1024, 1024, 1024, (unsigned)(256 * 1024 * 2), (unsigned)(256 * 1024 * 2)};
                pg8::StaticOrder S; S.init(M, 1024, G, bx);
                pg8::EpiRes E{R, R, 1024, DN_ALPHA};
                pg8::gemm_phase<pg8::EpiRes, pg8::StaticOrder, true>(ldsl, g, S, E);
            }
            grid.sync();
        }
        { const int lane = launder(lane0); for (int m = gw; m < M; m += NGW) ln_row(R + (size_t)m * D, Hb + (size_t)m * D, ln_mix_g + layer * D, ln_mix_b + layer * D, lane); }
        grid.sync();
        {
            pg8::Gemm g{Hb, W1_t + (size_t)layer * 4096 * 1024, 1024, 1024, 1024, (unsigned)(256 * 1024 * 2), (unsigned)(256 * 1024 * 2)};
            pg8::StaticOrder S; S.init(M, 4096, G, bx);
            pg8::EpiBf16<1> E{HID, 4096, 128};
            pg8::gemm_phase<pg8::EpiBf16<1>, pg8::StaticOrder, true>(ldsl, g, S, E);
        }
        grid.sync();
        {
            pg8::Gemm g{HID, W2_t + (size_t)layer * 1024 * 4096, 4096, 4096, 4096, (unsigned)(256 * 4096 * 2), (unsigned)(256 * 4096 * 2)};
            pg8::StaticOrder S; S.init(M, 1024, G, bx);
            pg8::EpiRes E{R, R, 1024, DN_ALPHA};
            pg8::gemm_phase<pg8::EpiRes, pg8::StaticOrder, true>(ldsl, g, S, E);
        }
        grid.sync();
        { const int lane = launder(lane0); for (int m = gw; m < M; m += NGW) ln_row(R + (size_t)m * D, layer == 0 ? Hb + (size_t)m * D : (bf16*)nullptr, ln_ffn_g + layer * D, ln_ffn_b + layer * D, lane); }
        if (layer == 0) grid.sync();
    }
}

extern "C" void kernel_launch(void* const* d_in, const int* in_sizes, int n_in, void* d_out, int out_size, void* d_ws, size_t ws_size, hipStream_t stream) {
    static int grid = 0;
    if (grid == 0) {
        if (n_in != 25 || in_sizes[0] != M * D || out_size != M * D || ws_size < WS_END) { fprintf(stderr, "kernel_launch: unexpected shapes (n_in %d, in0 %d, out %d, ws %zu)\n", n_in, n_in > 0 ? in_sizes[0] : -1, out_size, ws_size); grid = -1; return; }
        int dev = 0, cus = 0, per_cu = 0;
        if (hipGetDevice(&dev) != hipSuccess || hipDeviceGetAttribute(&cus, hipDeviceAttributeMultiprocessorCount, dev) != hipSuccess) { grid = -1; return; }
        if (hipFuncSetAttribute((const void*)mega_fwd, hipFuncAttributeMaxDynamicSharedMemorySize, LDS_BYTES) != hipSuccess) { fprintf(stderr, "kernel_launch: hipFuncSetAttribute failed\n"); grid = -1; return; }
        if (hipOccupancyMaxActiveBlocksPerMultiprocessor(&per_cu, (const void*)mega_fwd, NWAVES * 64, LDS_BYTES) != hipSuccess || per_cu < 1) per_cu = 1;
        (void)hipGetLastError();
        grid = cus;
    }
    if (grid < 0) return;
    Args a{};
    for (int i = 0; i < 25; ++i) a.in[i] = d_in[i];
    a.out = (float*)d_out; a.ws = (unsigned char*)d_ws;
    void* kargs[] = {&a};
    hipError_t e = hipLaunchCooperativeKernel((const void*)mega_fwd, dim3(grid), dim3(NWAVES * 64), kargs, LDS_BYTES, stream);
    if (e != hipSuccess) fprintf(stderr, "kernel_launch: cooperative launch failed: %s (grid %d)\n", hipGetErrorString(e), grid);
}
```

```cpp
#include <hip/hip_runtime.h>
#include <hip/hip_bf16.h>
#include <hip/hip_cooperative_groups.h>
#include <cstdio>
#include <cstdint>
namespace cg = cooperative_groups;
#ifndef PROBE
#define PROBE 0
#endif

namespace pg8 {
#define PG8_LAS __attribute__((address_space(3)))
typedef unsigned short bf16_t;
typedef short bf16x8 __attribute__((ext_vector_type(8)));
typedef float f32x4 __attribute__((ext_vector_type(4)));
typedef float f32x2 __attribute__((ext_vector_type(2)));
typedef unsigned u32x4 __attribute__((ext_vector_type(4)));
constexpr int BM = 256, BK = 64, HALF = 128, HTB = HALF * BK * 2, STAGE_BYTES = 8 * HTB, NXCD = 8, WGM = 8;

__host__ __device__ __forceinline__ int lds_byte(int r, int c) { const int st = (r >> 4) * 2 + (c >> 5), rr = r & 15, cc = c & 31, ob = rr * 64 + cc * 2; return st * 1024 + (ob ^ (((ob >> 9) & 1) << 5)); }
__host__ __device__ __forceinline__ void stage_rc(int b, int& R, int& C) { const int st = b / 1024, sb = b % 1024, swz = sb ^ (((sb >> 9) & 1) << 5); R = (st >> 1) * 16 + swz / 64; C = (st & 1) * 32 + (swz % 64) / 2; }
__host__ __device__ __forceinline__ int perm32(int rho) { const int n = rho >> 4, i = rho & 15; return 8 * (i >> 2) + 4 * n + (i & 3); }

struct Unit { int pm, pn; };
struct Gemm { const bf16_t* A; const bf16_t* Bt; int K, lda, ldb; unsigned tstepA, tstepB; };

struct StaticOrder {
    int nM, nN, nwg, G, c;
    __device__ void init(int M, int N, int G_, int c_) { nM = M / BM; nN = N / BM; nwg = nM * nN; G = G_; c = c_; }
    __device__ bool next(int i, Unit& u) const {
        const long L = (long)i * G + c; if (L >= nwg) return false;
        int wgid = (int)L; { const int q = nwg / NXCD, r = nwg % NXCD, xcd = wgid % NXCD, off = wgid / NXCD; wgid = (xcd < r ? xcd * (q + 1) : r * (q + 1) + (xcd - r) * q) + off; }
        const int nig = WGM * nN, gid = wgid / nig, fm = gid * WGM, gsz = (nM - fm) < WGM ? (nM - fm) : WGM;
        u.pm = fm + ((wgid % nig) % gsz); u.pn = (wgid % nig) / gsz; return true;
    }
};
struct BatchOrder {
    int nwg, G, c, mper, nper;
    __device__ void init(int ngroups, int mper_, int nper_, int G_, int c_) { mper = mper_; nper = nper_; nwg = ngroups * mper_ * nper_; G = G_; c = c_; }
    __device__ bool next(int i, Unit& u) const {
        const int L = i * G + c; if (L >= nwg) return false;
        const int per = mper * nper, g = L / per, r = L % per;
        u.pm = g * mper + r / nper; u.pn = g * nper + r % nper; return true;
    }
};

__device__ __forceinline__ unsigned cvt_pk_bf16(float lo, float hi) { unsigned r; asm volatile("v_cvt_pk_bf16_f32 %0, %1, %2" : "=v"(r) : "v"(lo), "v"(hi)); return r; }

typedef f32x4 Acc[2][2][4][2];

template <class Epi, class Sched, bool ALIGN_EPI>
__device__ __forceinline__ void gemm_phase(PG8_LAS unsigned char* lds, const Gemm g, const Sched& S, const Epi& E) {
    int tid_ = threadIdx.x; asm volatile("" : "+v"(tid_));
    const int tid = tid_, wid = __builtin_amdgcn_readfirstlane(tid >> 6), lane = tid & 63, wr = wid >> 2, wc = wid & 3, fr = lane & 15, fq = lane >> 4;
    const int K = g.K, nt = K / BK;
    unsigned voffA[2], voffB[2];
#pragma unroll
    for (int i = 0; i < 2; ++i) { int R, C; stage_rc(tid * 16 + i * 8192, R, C); const int Rb = Epi::PERM ? ((R & ~31) + perm32(R & 31)) : R;
        voffA[i] = (unsigned)(R * g.lda + C) * 2u; voffB[i] = (unsigned)(Rb * g.ldb + C) * 2u; }
    const size_t kstep = (size_t)(BK * 2);
    const size_t hstepA = (size_t)HALF * g.lda * 2, hstepB = (size_t)HALF * g.ldb * 2;
    const unsigned ldsw = (unsigned)wid * 1024u;
    const int aoff = lds_byte(wr * 64 + fr, fq * 8), boff = lds_byte(wc * 32 + fr, fq * 8);
#define PG8_SA(b, h) (((b) * 2 + (h)) * HTB)
#define PG8_SB(b, h) ((4 + (b) * 2 + (h)) * HTB)
#define PG8_STAGE(bufoff, gbase, voff) do { _Pragma("unroll") for (int _i = 0; _i < 2; ++_i) \
        __builtin_amdgcn_global_load_lds((const unsigned*)((const char*)(gbase) + (voff)[_i]), (PG8_LAS unsigned*)(lds + (bufoff) + ldsw + _i * 8192), 16, 0, 0); } while (0)
#define PG8_LDA(dst, b, h) do { _Pragma("unroll") for (int m = 0; m < 4; ++m) _Pragma("unroll") for (int k = 0; k < 2; ++k) dst[m][k] = *(const PG8_LAS bf16x8*)(lds + PG8_SA(b, h) + aoff + m * 2048 + k * 1024); } while (0)
#define PG8_LDB(dst, b, h) do { _Pragma("unroll") for (int n = 0; n < 2; ++n) _Pragma("unroll") for (int k = 0; k < 2; ++k) dst[n][k] = *(const PG8_LAS bf16x8*)(lds + PG8_SB(b, h) + boff + n * 2048 + k * 1024); } while (0)
#define PG8_MMA(ai, bj, At, Bt) do { __builtin_amdgcn_s_setprio(1); _Pragma("unroll") for (int m = 0; m < 4; ++m) _Pragma("unroll") for (int n = 0; n < 2; ++n) _Pragma("unroll") for (int k = 0; k < 2; ++k) \
        acc[ai][bj][m][n] = __builtin_amdgcn_mfma_f32_16x16x32_bf16(Bt[n][k], At[m][k], acc[ai][bj][m][n], 0, 0, 0); __builtin_amdgcn_s_setprio(0); } while (0)
#define PG8_WAIT_V(n) asm volatile("s_waitcnt vmcnt(" #n ")" ::: "memory")
#define PG8_WAIT_L(n) asm volatile("s_waitcnt lgkmcnt(" #n ")" ::: "memory")
#define PG8_BAR __builtin_amdgcn_s_barrier()
#define PG8_SCHED __builtin_amdgcn_sched_barrier(0)
    Unit cur, nxt; int ui = 0;
    if (!S.next(0, cur)) return;
    Acc acc;
#pragma unroll
    for (int a = 0; a < 2; ++a)
#pragma unroll
        for (int b = 0; b < 2; ++b)
#pragma unroll
            for (int m = 0; m < 4; ++m)
#pragma unroll
                for (int n = 0; n < 2; ++n) acc[a][b][m][n] = (f32x4){0.f, 0.f, 0.f, 0.f};
    bf16x8 At[4][2], B0[2][2], B1[2][2];
    const char* cA = (const char*)g.A + (size_t)cur.pm * g.tstepA; const char* cB = (const char*)g.Bt + (size_t)cur.pn * g.tstepB;
    PG8_STAGE(PG8_SB(0, 0), cB, voffB); PG8_STAGE(PG8_SB(0, 1), cB + hstepB, voffB); PG8_STAGE(PG8_SA(0, 0), cA, voffA); PG8_STAGE(PG8_SA(0, 1), cA + hstepA, voffA);
    if (wr == 1) PG8_BAR;
    PG8_WAIT_V(2); PG8_BAR;
    PG8_STAGE(PG8_SB(1, 0), cB + kstep, voffB); PG8_STAGE(PG8_SA(1, 0), cA + kstep, voffA); PG8_STAGE(PG8_SB(1, 1), cB + hstepB + kstep, voffB);
    PG8_WAIT_V(6); PG8_BAR;
    for (;;) {
        const bool has_next = S.next(ui + 1, nxt);
        const char* nA = has_next ? (const char*)g.A + (size_t)nxt.pm * g.tstepA : cA; const char* nB = has_next ? (const char*)g.Bt + (size_t)nxt.pn * g.tstepB : cB;
#pragma nounroll
        for (int t = 0; t < nt; t += 2) {
            const bool last = (t == nt - 2);
            const char* a1 = cA + (size_t)(t + 1) * kstep;
            const char* a2 = last ? nA : cA + (size_t)(t + 2) * kstep; const char* b2 = last ? nB : cB + (size_t)(t + 2) * kstep;
            const char* a3 = a2 + kstep; const char* b3 = b2 + kstep;
            PG8_LDB(B0, 0, 0); PG8_LDB(B1, 0, 1); PG8_SCHED; PG8_LDA(At, 0, 0); PG8_STAGE(PG8_SA(1, 1), a1 + hstepA, voffA);
            PG8_WAIT_V(8); PG8_WAIT_L(0); PG8_BAR; PG8_MMA(0, 0, At, B0); PG8_MMA(0, 1, At, B1); PG8_BAR; PG8_SCHED;
            PG8_LDA(At, 0, 1); PG8_STAGE(PG8_SB(0, 0), b2, voffB); PG8_STAGE(PG8_SB(0, 1), b2 + hstepB, voffB); PG8_STAGE(PG8_SA(0, 0), a2, voffA);
            PG8_WAIT_V(8); PG8_WAIT_L(0); PG8_BAR; PG8_MMA(1, 0, At, B0); PG8_MMA(1, 1, At, B1); PG8_BAR; PG8_SCHED;
            PG8_LDB(B0, 1, 0); PG8_LDB(B1, 1, 1); PG8_SCHED; PG8_LDA(At, 1, 0); PG8_STAGE(PG8_SA(0, 1), a2 + hstepA, voffA);
            PG8_WAIT_V(8); PG8_WAIT_L(0); PG8_BAR; PG8_MMA(0, 0, At, B0); PG8_MMA(0, 1, At, B1); PG8_BAR; PG8_SCHED;
            PG8_LDA(At, 1, 1); PG8_STAGE(PG8_SB(1, 0), b3, voffB); PG8_STAGE(PG8_SB(1, 1), b3 + hstepB, voffB); PG8_STAGE(PG8_SA(1, 0), a3, voffA);
            PG8_WAIT_V(8); PG8_WAIT_L(0); PG8_BAR; PG8_MMA(1, 0, At, B0); PG8_MMA(1, 1, At, B1); PG8_BAR; PG8_SCHED;
        }
        if constexpr (ALIGN_EPI) { if (wr == 0) PG8_BAR; }
        E(acc, cur, wr, wc, fr, fq);
        if (!has_next) break;
#pragma unroll
        for (int a = 0; a < 2; ++a)
#pragma unroll
            for (int b = 0; b < 2; ++b)
#pragma unroll
                for (int m = 0; m < 4; ++m)
#pragma unroll
                    for (int n = 0; n < 2; ++n) acc[a][b][m][n] = (f32x4){0.f, 0.f, 0.f, 0.f};
        cur = nxt; cA = nA; cB = nB; ++ui;
        if constexpr (ALIGN_EPI) { if (wr == 1) PG8_BAR; }
    }
    PG8_WAIT_V(0);
    if constexpr (!ALIGN_EPI) { if (wr == 0) PG8_BAR; }
    PG8_BAR;
#undef PG8_SA
#undef PG8_SB
#undef PG8_STAGE
#undef PG8_LDA
#undef PG8_LDB
#undef PG8_MMA
#undef PG8_WAIT_V
#undef PG8_WAIT_L
#undef PG8_BAR
#undef PG8_SCHED
}

__device__ __forceinline__ u32x4 pack8(f32x4 a, f32x4 b) { u32x4 w; w.x = cvt_pk_bf16(a[0], a[1]); w.y = cvt_pk_bf16(a[2], a[3]); w.z = cvt_pk_bf16(b[0], b[1]); w.w = cvt_pk_bf16(b[2], b[3]); return w; }

template <int ACT  > struct EpiBf16 {
    static constexpr bool PERM = true;
    bf16_t* O; int ldc; int gs;
    __device__ __forceinline__ void operator()(const Acc& acc, const Unit& u, int wr, int wc, int fr, int fq) const {
        const int row0 = u.pm * BM + wr * 64 + fr, col0 = u.pn * 2 * gs + wc * 32 + 8 * fq;
#pragma unroll
        for (int ai = 0; ai < 2; ++ai)
#pragma unroll
            for (int m = 0; m < 4; ++m) { bf16_t* rowp = O + (size_t)(row0 + ai * HALF + m * 16) * ldc + col0;
#pragma unroll
                for (int bj = 0; bj < 2; ++bj) { f32x4 v0 = acc[ai][bj][m][0], v1 = acc[ai][bj][m][1];
                    if (ACT == 1) { v0 = __builtin_elementwise_max(v0, (f32x4){0.f, 0.f, 0.f, 0.f}); v1 = __builtin_elementwise_max(v1, (f32x4){0.f, 0.f, 0.f, 0.f}); v0 = v0 * v0; v1 = v1 * v1; }
                    *(u32x4*)(rowp + bj * gs) = pack8(v0, v1); } }
    }
};
struct EpiGlu {
    static constexpr bool PERM = true;
    bf16_t* O; int ldc;
    __device__ __forceinline__ void operator()(const Acc& acc, const Unit& u, int wr, int wc, int fr, int fq) const {
        const int row0 = u.pm * BM + wr * 64 + fr, col0 = u.pn * HALF + wc * 32 + 8 * fq;
#pragma unroll
        for (int ai = 0; ai < 2; ++ai)
#pragma unroll
            for (int m = 0; m < 4; ++m) { bf16_t* rowp = O + (size_t)(row0 + ai * HALF + m * 16) * ldc + col0;
                f32x4 o[2];
#pragma unroll
                for (int n = 0; n < 2; ++n) { const f32x4 v = acc[ai][0][m][n], gt = acc[ai][1][m][n];
#pragma unroll
                    for (int j = 0; j < 4; ++j) o[n][j] = v[j] * __builtin_amdgcn_rcpf(1.0f + __expf(-gt[j])); }
                *(u32x4*)rowp = pack8(o[0], o[1]); }
    }
};
struct EpiRes {
    static constexpr bool PERM = false;
    const float* base; float* R; int ldc; float alpha;
    __device__ __forceinline__ void operator()(const Acc& acc, const Unit& u, int wr, int wc, int fr, int fq) const {
        const int row0 = u.pm * BM + wr * 64 + fr, col0 = u.pn * BM + wc * 32 + 4 * fq;
#pragma unroll
        for (int ai = 0; ai < 2; ++ai)
#pragma unroll
            for (int m = 0; m < 4; ++m) { const size_t off = (size_t)(row0 + ai * HALF + m * 16) * ldc + col0;
                f32x4 bs[2][2];
#pragma unroll
                for (int bj = 0; bj < 2; ++bj)
#pragma unroll
                    for (int n = 0; n < 2; ++n) bs[bj][n] = *(const f32x4*)(base + off + bj * HALF + n * 16);
#pragma unroll
                for (int bj = 0; bj < 2; ++bj)
#pragma unroll
                    for (int n = 0; n < 2; ++n) *(f32x4*)(R + off + bj * HALF + n * 16) = bs[bj][n] * alpha + acc[ai][bj][m][n];
                asm volatile("" ::: "memory"); }
    }
};
struct EpiF32 {
    static constexpr bool PERM = false;
    float* O; int ldc;
    __device__ __forceinline__ void operator()(const Acc& acc, const Unit& u, int wr, int wc, int fr, int fq) const {
        const int row0 = u.pm * BM + wr * 64 + fr, col0 = u.pn * BM + wc * 32 + 4 * fq;
#pragma unroll
        for (int ai = 0; ai < 2; ++ai)
#pragma unroll
            for (int m = 0; m < 4; ++m) { const size_t off = (size_t)(row0 + ai * HALF + m * 16) * ldc + col0;
#pragma unroll
                for (int bj = 0; bj < 2; ++bj)
#pragma unroll
                    for (int n = 0; n < 2; ++n) *(f32x4*)(O + off + bj * HALF + n * 16) = acc[ai][bj][m][n]; }
    }
};
struct EpiS1 {
    static constexpr bool PERM = false;
    float* E;
    __device__ __forceinline__ void operator()(const Acc& acc, const Unit& u, int wr, int wc, int fr, int fq) const {
        const int row0 = u.pm * BM + wr * 64 + fr, col0 = wc * 32 + 4 * fq;
#pragma unroll
        for (int ai = 0; ai < 2; ++ai)
#pragma unroll
            for (int m = 0; m < 4; ++m) { const size_t off = (size_t)(row0 + ai * HALF + m * 16) * 128 + col0;
#pragma unroll
                for (int n = 0; n < 2; ++n) *(f32x4*)(E + off + n * 16) = acc[ai][0][m][n]; }
    }
};
struct EpiS3 {
    static constexpr bool PERM = true;
    bf16_t* Y;
    __device__ __forceinline__ void operator()(const Acc& acc, const Unit& u, int wr, int wc, int fr, int fq) const {
        const int g = u.pm >> 2, rloc = (u.pm & 3) * BM + wr * 64 + fr;
        const int co0 = 8 * (fq & 1);
#pragma unroll
        for (int ai = 0; ai < 2; ++ai)
#pragma unroll
            for (int m = 0; m < 4; ++m) { const int r = rloc + ai * HALF + m * 16;
#pragma unroll
                for (int bj = 0; bj < 2; ++bj) { const int t = 16 * (u.pn & 1) + 8 * bj + 2 * wc + (fq >> 1);
                    f32x4 o[2];
#pragma unroll
                    for (int n = 0; n < 2; ++n)
#pragma unroll
                        for (int j = 0; j < 4; ++j) { const float v = acc[ai][bj][m][n][j]; const float z = 1.5957691216f * (v + 0.044715f * v * v * v);
                            o[n][j] = v * __builtin_amdgcn_rcpf(1.0f + __expf(-z)); }
                    *(u32x4*)(Y + ((size_t)r * 32 + t) * 1024 + g * 16 + co0) = pack8(o[0], o[1]); } }
    }
};
struct EpiQ {
    static constexpr bool PERM = true;
    bf16_t* Q; const float* CS;
    __device__ __forceinline__ void operator()(const Acc& acc, const Unit& u, int wr, int wc, int fr, int fq) const {
        const int row0 = u.pm * BM + wr * 64 + fr;
        const int h = u.pn * 4 + wc, i0 = 8 * fq;
#pragma unroll
        for (int ai = 0; ai < 2; ++ai)
#pragma unroll
            for (int m = 0; m < 4; ++m) { const int row = row0 + ai * HALF + m * 16;
                f32x4 o1[2], o2[2];
#pragma unroll
                for (int n = 0; n < 2; ++n) { const f32x4 cs = *(const f32x4*)(CS + (size_t)row * 64 + i0 + 4 * n), sn = *(const f32x4*)(CS + (size_t)row * 64 + 32 + i0 + 4 * n);
                    const f32x4 x1 = acc[ai][0][m][n], x2 = acc[ai][1][m][n];
                    o1[n] = x1 * cs - x2 * sn; o2[n] = x1 * sn + x2 * cs; }
                bf16_t* qp = Q + (size_t)row * 1536 + h * 192 + 128 + i0;
                *(u32x4*)qp = pack8(o1[0], o1[1]); *(u32x4*)(qp + 32) = pack8(o2[0], o2[1]);
                asm volatile("" ::: "memory"); }
    }
};
}

namespace att {
using bf16 = __hip_bfloat16;
typedef short bf16x8 __attribute__((ext_vector_type(8)));
typedef short s16x4 __attribute__((ext_vector_type(4)));
typedef float f32x16 __attribute__((ext_vector_type(16)));
typedef float f32x4 __attribute__((ext_vector_type(4)));
typedef unsigned u32x4 __attribute__((ext_vector_type(4)));
constexpr int NW = 8, QBLK = 32, KVBLK = 64, QB = NW * QBLK, DV = 128, DK = 192;
constexpr int SEQ = 4096, NQB = SEQ / QB;
constexpr int QS = 1536, KVS = 2048, KRS = 64, OS = 1024;
constexpr int SHM_V = KVBLK * DV * 2, SHM_K = KVBLK * DK * 2;
constexpr int NQR = 4, NQLDS = 12 - NQR, QSLOT = NQLDS * 1024;
constexpr int WS_OFF = 2 * SHM_V + 2 * SHM_K, QR_OFF = WS_OFF + NW * 64 * 4, LDS_BYTES = QR_OFF + NW * QSLOT;
constexpr float SCALE = 0.07216878364870322f;
constexpr float THR = 8.f;
#define KSWZ(row, colB) ((row) * 384 + ((colB) ^ (((row) & 7) << 4)))
#define SBAR() __builtin_amdgcn_sched_barrier(0)
__device__ __forceinline__ int v_st(int k, int c) { const int kk = (k & ~0xC) | ((k & 4) << 1) | ((k & 8) >> 1); return ((kk >> 3) * 4 + (c >> 5)) * 512 + ((kk & 7) * 32 + (c & 31)) * 2; }
__device__ __forceinline__ int v_rd_base(int lane) { return ((lane & 3) << 3) | (((lane >> 2) & 3) << 6) | (((lane >> 4) & 1) << 5) | (((lane >> 5) & 1) << 8); }
constexpr int v_rd_off(int d0, int ks, int half) { return d0 * 512 + ks * 4096 + half * 2048; }
__device__ __forceinline__ int crow(int r, int hi) { return (r & 3) + 8 * (r >> 2) + 4 * hi; }
__device__ __forceinline__ unsigned cvtpk(float lo, float hi) { unsigned r; asm volatile("v_cvt_pk_bf16_f32 %0, %1, %2" : "=v"(r) : "v"(lo), "v"(hi)); return r; }
__device__ __forceinline__ bf16x8 load8(const bf16* p) { return *reinterpret_cast<const bf16x8*>(p); }
__device__ __forceinline__ void mask_tile(f32x16& p0, f32x16& p1, int dq, unsigned W) {
    const float NEG = -__builtin_inff();
#pragma unroll
    for (int r = 0; r < 16; ++r) {
        const int c = (r & 3) + 8 * (r >> 2);
        if ((unsigned)(dq - c) >= W) p0[r] = NEG;
        if ((unsigned)(dq - c - 32) >= W) p1[r] = NEG;
    }
}
__device__ __forceinline__ void partialSM(f32x16& p0, f32x16& p1, float& m_reg, float& mn, float& alpha) {
    float pmax = p0[0]; for (int r = 1; r < 16; ++r) pmax = fmaxf(pmax, p0[r]); for (int r = 0; r < 16; ++r) pmax = fmaxf(pmax, p1[r]);
    { auto rr = __builtin_amdgcn_permlane32_swap(__float_as_uint(pmax), __float_as_uint(pmax), false, false);
      pmax = fmaxf(__uint_as_float(rr[0]), __uint_as_float(rr[1])); }
    constexpr float C2 = 1.4426950408889634f * SCALE;
    if (__builtin_expect(__all((pmax - m_reg) * SCALE <= THR), 1)) { mn = m_reg; alpha = 1.f; }
    else { mn = fmaxf(m_reg, pmax); alpha = __builtin_amdgcn_exp2f((m_reg - mn) * C2); m_reg = mn; }
    const float mnL = -mn * C2;
    for (int r = 0; r < 16; ++r) p0[r] = fmaf(p0[r], C2, mnL); for (int r = 0; r < 16; ++r) p1[r] = fmaf(p1[r], C2, mnL);
    for (int r = 0; r < 16; ++r) p0[r] = __builtin_amdgcn_exp2f(p0[r]);
}
__device__ __forceinline__ void finishSM(f32x16& p0, f32x16& p1, float alpha, float& l_reg, bf16x8& pa0, bf16x8& pa1, bf16x8& pa2, bf16x8& pa3) {
    for (int r = 0; r < 16; ++r) p1[r] = __builtin_amdgcn_exp2f(p1[r]);
    float ps = 0; for (int r = 0; r < 16; ++r) ps += p0[r]; for (int r = 0; r < 16; ++r) ps += p1[r];
    { auto rr = __builtin_amdgcn_permlane32_swap(__float_as_uint(ps), __float_as_uint(ps), false, false);
      ps = __uint_as_float(rr[0]) + __uint_as_float(rr[1]); }
    l_reg = l_reg * alpha + ps;
#define PK4(P, B_, OUT) do { unsigned a0 = cvtpk(P[B_+0], P[B_+1]), a1 = cvtpk(P[B_+2], P[B_+3]);                          \
        unsigned b0 = cvtpk(P[B_+4], P[B_+5]), b1 = cvtpk(P[B_+6], P[B_+7]);                                             \
        auto r0 = __builtin_amdgcn_permlane32_swap(a0, b0, false, false); auto r1 = __builtin_amdgcn_permlane32_swap(a1, b1, false, false); \
        u32x4 w = {r0[0], r1[0], r0[1], r1[1]}; OUT = *reinterpret_cast<bf16x8*>(&w); } while (0)
    PK4(p0, 0, pa0); PK4(p0, 8, pa1); PK4(p1, 0, pa2); PK4(p1, 8, pa3);
#undef PK4
}
template <int KB>
__device__ __forceinline__ void qkt(f32x16& p0, f32x16& p1, const char* K_lds, int r32, int hi, const bf16x8* qr, const char* qrope) {
    p0 = f32x16{}; p1 = f32x16{};
    const char* kb[4];
#pragma unroll
    for (int dd = 0; dd < 4; ++dd) kb[dd] = K_lds + KB * SHM_K + KSWZ(r32, (dd * 16 + hi * 8) * 2);
#pragma unroll
    for (int d0 = 0; d0 < NQR; ++d0) { const char* a = kb[d0 & 3] + (d0 >> 2) * 128;
        bf16x8 b0 = *reinterpret_cast<const bf16x8*>(a);
        bf16x8 b1 = *reinterpret_cast<const bf16x8*>(a + 32 * 384);
        p0 = __builtin_amdgcn_mfma_f32_32x32x16_bf16(b0, qr[d0], p0, 0, 0, 0);
        p1 = __builtin_amdgcn_mfma_f32_32x32x16_bf16(b1, qr[d0], p1, 0, 0, 0); }
#pragma unroll
    for (int d0 = NQR; d0 < 12; ++d0) { const char* a = kb[d0 & 3] + (d0 >> 2) * 128;
        bf16x8 b0 = *reinterpret_cast<const bf16x8*>(a);
        bf16x8 b1 = *reinterpret_cast<const bf16x8*>(a + 32 * 384);
        bf16x8 q = *reinterpret_cast<const bf16x8*>(qrope + (d0 - NQR) * 1024);
        p0 = __builtin_amdgcn_mfma_f32_32x32x16_bf16(b0, q, p0, 0, 0, 0);
        p1 = __builtin_amdgcn_mfma_f32_32x32x16_bf16(b1, q, p1, 0, 0, 0);
        if (d0 == 7) SBAR(); }
}
template <int VB>
__device__ __forceinline__ void pv_tile(f32x16* o, int vb0, bf16x8 pa0, bf16x8 pa1, bf16x8 pa2, bf16x8 pa3) {
#define TRRD(dst, off) asm volatile("ds_read_b64_tr_b16 %0, %1 offset:%2" : "=&v"(dst) : "v"(vb0), "i"(off) : "memory")
#define PV_D0(d0) do { s16x4 l0, l1, l2, l3, h0, h1, h2, h3; constexpr int b_ = VB * SHM_V + v_rd_off(d0, 0, 0); \
        TRRD(l0, b_); TRRD(h0, b_ + 2048); TRRD(l1, b_ + 4096); TRRD(h1, b_ + 6144); TRRD(l2, b_ + 8192); TRRD(h2, b_ + 10240); TRRD(l3, b_ + 12288); TRRD(h3, b_ + 14336); \
        asm volatile("s_waitcnt lgkmcnt(0)" ::: "memory"); SBAR();   \
        o[d0] = __builtin_amdgcn_mfma_f32_32x32x16_bf16(pa0, (bf16x8){l0[0], l0[1], l0[2], l0[3], h0[0], h0[1], h0[2], h0[3]}, o[d0], 0, 0, 0);   \
        o[d0] = __builtin_amdgcn_mfma_f32_32x32x16_bf16(pa1, (bf16x8){l1[0], l1[1], l1[2], l1[3], h1[0], h1[1], h1[2], h1[3]}, o[d0], 0, 0, 0);   \
        o[d0] = __builtin_amdgcn_mfma_f32_32x32x16_bf16(pa2, (bf16x8){l2[0], l2[1], l2[2], l2[3], h2[0], h2[1], h2[2], h2[3]}, o[d0], 0, 0, 0);   \
        o[d0] = __builtin_amdgcn_mfma_f32_32x32x16_bf16(pa3, (bf16x8){l3[0], l3[1], l3[2], l3[3], h3[0], h3[1], h3[2], h3[3]}, o[d0], 0, 0, 0); } while (0)
    PV_D0(0); PV_D0(1); PV_D0(2); PV_D0(3);
#undef PV_D0
#undef TRRD
}
struct BlockRef { const bf16* Q; const bf16* K; const bf16* V; const bf16* KR; bf16* O; int P0; };
struct Tensors { const bf16* Q; const bf16* KV; const bf16* KR; bf16* O; };
__device__ __forceinline__ BlockRef mk_ref(const Tensors& T, int bh, int qb) {
    const int b = bh >> 3, h = bh & 7; BlockRef r;
    r.Q = T.Q + ((size_t)b * SEQ + (size_t)qb * QB) * QS + h * DK;
    r.K = T.KV + (size_t)b * SEQ * KVS + h * 256; r.V = r.K + 128;
    r.KR = T.KR + (size_t)b * SEQ * KRS;
    r.O = T.O + ((size_t)b * SEQ + (size_t)qb * QB) * OS + h * DV; r.P0 = qb * QB;
    return r;
}
struct Seam { bf16x8 qr[NQR]; bf16x8 st_v0, st_v1, st_k0, st_k1, st_k2; };
#define ROWK(p, k0, rr) (((p) + (size_t)(k0) * KVS) + (unsigned)((rr) * KVS + sc))
#define VMW() asm volatile("s_waitcnt vmcnt(0)" ::: "memory")
#define VMWN(n) asm volatile("s_waitcnt vmcnt(%0)" :: "i"(n) : "memory")
#define SLOAD_H(Kp, Vp, KRp, k0) do { S.st_v0 = load8(ROWK(Vp, k0, sr)); S.st_v1 = load8(ROWK(Vp, k0, 32 + sr));              \
                         S.st_k0 = load8(ROWK(Kp, k0, sr)); S.st_k1 = load8(ROWK(Kp, k0, 32 + sr)); S.st_k2 = load8(((KRp) + (size_t)(k0) * KRS) + (unsigned)(rr8 * KRS + rc8)); } while (0)
#define SWRITE_HK(bf) do { *(bf16x8*)(K_lds + (bf) * SHM_K + kws) = S.st_k0; *(bf16x8*)(K_lds + (bf) * SHM_K + kws + 32 * 384) = S.st_k1; *(bf16x8*)(K_lds + (bf) * SHM_K + kws2) = S.st_k2; } while (0)
#define SWRITE_HV(bf) do { *(bf16x8*)(V_lds + (bf) * SHM_V + vst0) = S.st_v0; *(bf16x8*)(V_lds + (bf) * SHM_V + vst1) = S.st_v1; } while (0)
#define SWRITE_H(bf) do { SWRITE_HV(bf); SWRITE_HK(bf); } while (0)
__device__ __forceinline__ void attn_prime(const BlockRef& cur, char* lds, Seam& S) {
    int tid_ = threadIdx.x; asm volatile("" : "+v"(tid_));
    const int tid = tid_, wid = __builtin_amdgcn_readfirstlane(tid >> 6), lane = tid & 63, r32 = lane & 31, hi = lane >> 5;
    const int sr = tid >> 4, sc = (tid & 15) * 8, kws = KSWZ(sr, sc * 2), rr8 = tid >> 3, rc8 = (tid & 7) * 8, kws2 = KSWZ(rr8, (128 + rc8) * 2); char* K_lds = lds + 2 * SHM_V;
    char* qrope = lds + QR_OFF + wid * QSLOT + lane * 16;
    const bf16* qrow = cur.Q + (size_t)(wid * QBLK + r32) * QS + hi * 8;
#pragma unroll
    for (int d0 = 0; d0 < NQR; ++d0) S.qr[d0] = load8(qrow + d0 * 16);
#pragma unroll
    for (int d0 = NQR; d0 < 12; ++d0) *(bf16x8*)(qrope + (d0 - NQR) * 1024) = load8(qrow + d0 * 16);
    SLOAD_H(cur.K, cur.V, cur.KR, 0); VMW(); SWRITE_HK(0);
    __syncthreads();
}
__device__ __forceinline__ void attn_block(const Tensors& T, int bh, int qb, int bhn, int qbn, char* lds, Seam& S) {
    const BlockRef cur = mk_ref(T, bh, qb);
    int tid_ = threadIdx.x; asm volatile("" : "+v"(tid_));
    const int tid = tid_, wid = __builtin_amdgcn_readfirstlane(tid >> 6), lane = tid & 63, r32 = lane & 31, hi = lane >> 5;
    constexpr int W = SEQ;
    const int NT = (cur.P0 + QB - 1) / KVBLK + 1;
    const int qlo = cur.P0 + wid * QBLK, qm = qlo + r32 - 4 * hi;
    char* V_lds = lds; char* K_lds = lds + 2 * SHM_V;
    float* ws = (float*)(lds + WS_OFF) + wid * 64; float* li_l = ws, * al_l = ws + 32;
    char* qrope = lds + QR_OFF + wid * QSLOT + lane * 16;
    float m_reg = -1e30f, l_reg = 0; f32x16 o[4] = {};
    const int sr = tid >> 4, sc = (tid & 15) * 8, vst0 = v_st(sr, sc), vst1 = v_st(32 + sr, sc), kws = KSWZ(sr, sc * 2);
    const int rr8 = tid >> 3, rc8 = (tid & 7) * 8, kws2 = KSWZ(rr8, (128 + rc8) * 2);
    const int vb0 = (int)(uintptr_t)V_lds + v_rd_base(lane);
    const bf16* Kh = cur.K; const bf16* Vh = cur.V; const bf16* KRh = cur.KR;
#define RESC(a) do { if (__any((a) < 1.f)) { if (hi == 0) al_l[r32] = (a); asm volatile("s_waitcnt lgkmcnt(0)" ::: "memory");              \
                     for (int d_ = 0; d_ < 4; ++d_) for (int r = 0; r < 16; ++r) o[d_][r] *= al_l[crow(r, hi)]; } } while (0)
#define KBASE(t) ((t) * KVBLK)
#define MASKT(P0_, P1_, t) do { const int kb_ = KBASE(t); if (kb_ + KVBLK - 1 > qlo) mask_tile(P0_, P1_, qm - kb_, (unsigned)W); } while (0)
    constexpr int NQL = NQR;
#define SEAM_K0() do { VMWN(NQL); SWRITE_HK(0); SBAR(); } while (0)
    f32x16 pA0, pA1, pB0, pB1; float mnA, mnB, alA, alB; bf16x8 pa0, pa1, pa2, pa3;
    SWRITE_HV(0); SBAR();
    if (NT > 1) { SLOAD_H(Kh, Vh, KRh, KBASE(1)); }
    SBAR(); qkt<0>(pA0, pA1, K_lds, r32, hi, S.qr, qrope);
    MASKT(pA0, pA1, 0); partialSM(pA0, pA1, m_reg, mnA, alA);
    if (NT > 1) { VMW(); SWRITE_H(1); }
    __syncthreads();
#define HALF_STEP(PX0, PX1, mnX, alX, PY0, PY1, alY, t, KB, VB, SB) do {                                                      \
        SBAR(); qkt<KB>(PX0, PX1, K_lds, r32, hi, S.qr, qrope);                                                               \
        finishSM(PY0, PY1, alY, l_reg, pa0, pa1, pa2, pa3); SBAR();                                                           \
        if ((t) + 1 < NT) { SLOAD_H(Kh, Vh, KRh, KBASE((t) + 1)); SBAR(); }                                                   \
        pv_tile<VB>(o, vb0, pa0, pa1, pa2, pa3); MASKT(PX0, PX1, (t)); partialSM(PX0, PX1, m_reg, mnX, alX);                  \
        __syncthreads();                                                                                                      \
        if ((t) + 1 < NT) { VMW(); SWRITE_H(SB); }                                                                            \
        RESC(alX); __syncthreads(); } while (0)
    for (int t = 1; t + 1 < NT; t += 2) {
        HALF_STEP(pB0, pB1, mnB, alB, pA0, pA1, alA, t, 1, 0, 0);
        HALF_STEP(pA0, pA1, mnA, alA, pB0, pB1, alB, t + 1, 0, 1, 1);
    }
    const bool even = (NT & 1) == 0;
    if (even) { SBAR(); qkt<1>(pB0, pB1, K_lds, r32, hi, S.qr, qrope); SBAR(); }
    const bf16* nqrow;
    { const BlockRef nxt = mk_ref(T, bhn, qbn);
      SLOAD_H(nxt.K, nxt.V, nxt.KR, 0); SBAR();
      nqrow = nxt.Q + (size_t)(wid * QBLK + r32) * QS + hi * 8; }
#pragma unroll
    for (int d0 = 0; d0 < NQR; ++d0) S.qr[d0] = load8(nqrow + d0 * 16);
    SBAR();
    finishSM(pA0, pA1, alA, l_reg, pa0, pa1, pa2, pa3); SBAR();
    pv_tile<0>(o, vb0, pa0, pa1, pa2, pa3);
    if (even) { MASKT(pB0, pB1, NT - 1); partialSM(pB0, pB1, m_reg, mnB, alB); __syncthreads(); RESC(alB);
        finishSM(pB0, pB1, alB, l_reg, pa0, pa1, pa2, pa3); SBAR(); pv_tile<1>(o, vb0, pa0, pa1, pa2, pa3); }
    SBAR(); SEAM_K0();
    if (hi == 0) li_l[r32] = l_reg; asm volatile("s_waitcnt lgkmcnt(0)" ::: "memory");
    float rli[16];
#pragma unroll
    for (int r = 0; r < 16; ++r) rli[r] = __builtin_amdgcn_rcpf(li_l[crow(r, hi)]);
    bf16* Ow = mk_ref(T, bh, qb).O + (size_t)(wid * QBLK) * OS;
#pragma unroll
    for (int r = 0; r < 16; ++r) { const int orow = crow(r, hi);
#pragma unroll
        for (int d0 = 0; d0 < 4; ++d0) { const float v = o[d0][r] * rli[r];
            const float vn = __shfl_xor(v, 1);
            if ((r32 & 1) == 0) *(unsigned*)(Ow + (size_t)orow * OS + d0 * 32 + r32) = cvtpk(v, vn); } }
#pragma unroll
    for (int d0 = NQR; d0 < 12; ++d0) *(bf16x8*)(qrope + (d0 - NQR) * 1024) = load8(nqrow + d0 * 16);
    __syncthreads();
#undef RESC
#undef KBASE
#undef MASKT
#undef SEAM_K0
#undef HALF_STEP
}
#undef ROWK
#undef VMW
#undef VMWN
#undef SLOAD_H
#undef SWRITE_HK
#undef SWRITE_HV
#undef SWRITE_H
__device__ __forceinline__ void attn_phase(char* lds, const Tensors& T, int G, int vcu) {
    constexpr int NX = NQB / 2, TOTAL = 64 * NX;
    int L = vcu; if (L >= TOTAL) return;
    int bh = L / NX, x = L % NX, pass = 0;
    Seam S;
    { const BlockRef c0 = mk_ref(T, bh, x); attn_prime(c0, lds, S); }
#pragma nounroll
    for (;;) {
        const bool more_pass = pass == 0, more_item = L + G < TOTAL, last = !more_pass && !more_item;
        int bhn = bh, xn = x, passn = pass + 1, Ln = L;
        if (!more_pass) { passn = 0; Ln = more_item ? L + G : L; bhn = Ln / NX; xn = Ln % NX; }
        const int qb = pass ? NQB - 1 - x : x, qbn = last ? qb : (passn ? NQB - 1 - xn : xn);
        attn_block(T, bh, qb, last ? bh : bhn, qbn, lds, S);
        if (last) break;
        bh = bhn; x = xn; pass = passn; L = Ln;
    }
}
}

constexpr int NWAVES = 8;
constexpr int BATCH = 8, SEQ = 4096, D = 1024, FF = 4096, M = BATCH * SEQ;
constexpr int NG = 64, NP = 64, CH = 32, NCH = SEQ / CH, XG_LD = 640, RPG = BATCH * NCH;
constexpr float LN_EPS = 1e-5f, RMS_EPS = 1e-6f, DN_ALPHA = 1.4142135623730951f;
constexpr size_t MiB = 1u << 20;
constexpr size_t WS_WGLU = 1 * MiB, WS_WOUT = 5 * MiB, WS_W1 = 7 * MiB, WS_W2 = 23 * MiB, WS_WQKVA = 39 * MiB, WS_WKVB = 41 * MiB, WS_WQB = 42 * MiB, WS_WO = 44 * MiB;
constexpr size_t WS_W1G = 46 * MiB, WS_TG = 55 * MiB, WS_KBUF = 95 * MiB, WS_AL = 97 * MiB, WS_XG = 98 * MiB, WS_E = 178 * MiB, WS_YACT = 210 * MiB, WS_G = 274 * MiB;
constexpr size_t WS_HB = 400 * MiB, WS_HID = 98 * MiB;
constexpr size_t WS_CQKV = 98 * MiB, WS_CKV = 194 * MiB, WS_CQ = 210 * MiB, WS_KR = 234 * MiB, WS_CS = 238 * MiB, WS_KV = 246 * MiB, WS_Q = 374 * MiB, WS_O = 98 * MiB;
constexpr size_t WS_END = 470 * MiB;
constexpr int LDS_BYTES = 153600, MISC_OFF = 153600 - 512;
static_assert(att::LDS_BYTES <= MISC_OFF && pg8::STAGE_BYTES <= MISC_OFF, "LDS map");

#define GAS __attribute__((address_space(1)))
#define LAS __attribute__((address_space(3)))
typedef unsigned short bf16;
typedef unsigned v4u __attribute__((ext_vector_type(4)));
typedef unsigned v2u __attribute__((ext_vector_type(2)));
typedef float f32x4 __attribute__((ext_vector_type(4)));
typedef float f32x2 __attribute__((ext_vector_type(2)));
#define LDS_WAIT() asm volatile("s_waitcnt lgkmcnt(0)" ::: "memory")
__device__ __forceinline__ unsigned f2bf(float f) { unsigned u = __builtin_bit_cast(unsigned, f); return (u + 0x7fffu + ((u >> 16) & 1u)) >> 16; }
__device__ __forceinline__ unsigned pk2(float lo, float hi) { return f2bf(lo) | (f2bf(hi) << 16); }
__device__ __forceinline__ float wave_sum(float v) {
#pragma unroll
    for (int o = 1; o < 64; o <<= 1) v += __shfl_xor(v, o);
    return v;
}
__device__ __forceinline__ void sincos_red(float ang, float& s, float& c) {
    const float n = rintf(ang * 0.15915494309189535f);
    float r = fmaf(-n, 6.2831854820251465f, ang); r = fmaf(-n, -1.7484556e-7f, r);
    s = sinf(r); c = cosf(r);
}
__device__ __forceinline__ void cpow_a(float lrdt, float lidt, float k, float& re, float& im) {
    const float mag = expf(k * lrdt); float s, c; sincos_red(k * lidt, s, c); re = mag * c; im = mag * s;
}


__device__ __forceinline__ const void* argp(volatile LAS unsigned* misc, int i) {
    const unsigned lo = __builtin_amdgcn_readfirstlane(misc[16 + 2 * i]), hi = __builtin_amdgcn_readfirstlane(misc[16 + 2 * i + 1]);
    return (const void*)(((unsigned long long)hi << 32) | lo);
}
#define XB_TMO      128
#define XB_XCNT(j)  (256  + 64 * (j))
#define XB_XSUB(j)  (1280 + 64 * (j))
#define XB_XGEN(j)  (2304 + 64 * (j))
#define XB_TOP      3328
#define XB_TOPGEN   3392
#define XCD_BAR_WORDS 3456
#define XB_SPIN_CAP (1u << 22)
__device__ __forceinline__ unsigned xb_ld(unsigned* p)              { return __hip_atomic_load(p, __ATOMIC_RELAXED, __HIP_MEMORY_SCOPE_AGENT); }
__device__ __forceinline__ unsigned xb_add(unsigned* p, unsigned v) { return __hip_atomic_fetch_add(p, v, __ATOMIC_RELAXED, __HIP_MEMORY_SCOPE_AGENT); }
__device__ __forceinline__ unsigned xb_xcc_id() { return (unsigned)__builtin_amdgcn_s_getreg((3 << 11) | 20) & 0xFu; }
#define XB_SPIN(cond, bar) do { unsigned _sp = 0; while (cond) { __builtin_amdgcn_s_sleep(1); \
    if ((++_sp & 255u) == 0u) { if (xb_ld(&(bar)[XB_TMO])) break; if (_sp > XB_SPIN_CAP) { atomicAdd(&(bar)[XB_TMO], 1u); break; } } } } while (0)
struct XcdBarrier { unsigned* bar; unsigned x; volatile LAS unsigned* st; };
__device__ __forceinline__ XcdBarrier xcd_barrier_post(unsigned* bar, volatile LAS unsigned* st) {
    XcdBarrier b; b.bar = bar; b.x = xb_xcc_id(); b.st = st;
    if (threadIdx.x == 0) (void)xb_add(&bar[XB_XCNT(b.x)], 1u);
    return b;
}
__device__ __forceinline__ void xcd_barrier_complete(unsigned* bar, unsigned x, unsigned& nloc, unsigned& nx) {
    const unsigned G = gridDim.x * gridDim.y * gridDim.z;
    unsigned sum, cnt, mine, sp = 0u;
    for (;;) {
        sum = 0u; cnt = 0u; mine = 0u;
#pragma unroll
        for (unsigned j = 0; j < 16; ++j) { const unsigned c = xb_ld(&bar[XB_XCNT(j)]); sum += c; cnt += (c > 0u) ? 1u : 0u; mine = (j == x) ? c : mine; }
        if (sum == G) break;
        __builtin_amdgcn_s_sleep(1);
        if ((++sp & 255u) == 0u) { if (xb_ld(&bar[XB_TMO])) break; if (sp > XB_SPIN_CAP) { atomicAdd(&bar[XB_TMO], 1u); break; } }
    }
    nloc = mine > 0u ? mine : 1u; nx = cnt > 0u ? cnt : 1u;
}
__device__ __forceinline__ void xcd_barrier(volatile LAS unsigned* misc) {
    asm volatile("s_waitcnt vmcnt(0)" ::: "memory");
    __syncthreads();
    if (threadIdx.x == 0) {
        XcdBarrier b; b.bar = (unsigned*)argp(misc, 26); b.x = misc[10]; b.st = misc + 8;
        unsigned* bar = b.bar;
        __builtin_amdgcn_s_waitcnt(0);
        unsigned nloc = b.st[0], nx = b.st[1];
        if (nloc == 0u) { xcd_barrier_complete(bar, b.x, nloc, nx); b.st[0] = nloc; b.st[1] = nx; }
        const unsigned old = xb_add(&bar[XB_XSUB(b.x)], 1u);
        const unsigned gen = old / nloc;
        if (old + 1u == (gen + 1u) * nloc) {
            __builtin_amdgcn_fence(__ATOMIC_RELEASE, "agent");
            asm volatile("s_waitcnt vmcnt(0)" ::: "memory");
            const unsigned og = xb_add(&bar[XB_TOP], 1u);
            const unsigned tg = og / nx;
            if (og + 1u == (tg + 1u) * nx) xb_add(&bar[XB_TOPGEN], 1u);
            else XB_SPIN(xb_ld(&bar[XB_TOPGEN]) == tg, bar);
            __builtin_amdgcn_fence(__ATOMIC_ACQUIRE, "agent");
            xb_add(&bar[XB_XGEN(b.x)], 1u);
            asm volatile("s_waitcnt vmcnt(0)" ::: "memory");
        } else {
            XB_SPIN(xb_ld(&bar[XB_XGEN(b.x)]) == gen, bar);
            __builtin_amdgcn_fence(__ATOMIC_ACQUIRE, "agent");
            asm volatile("s_waitcnt vmcnt(0)" ::: "memory");
        }
    }
    __syncthreads();
}

struct Args { const void* in[25]; float* out; unsigned char* ws; };
__device__ __forceinline__ int launder(int v) { asm volatile("" : "+v"(v)); return v; }

__device__ __forceinline__ int map_row(int mode, int n0) {
    if (mode == 0) return n0;
    if (mode == 1) { const int gate = n0 >= 1024, c = gate ? n0 - 1024 : n0; return 256 * (c >> 7) + (gate ? 128 : 0) + (c & 127); }
    const int h = n0 / 192, d = n0 % 192;
    if (d < 128) return h * 128 + d;
    const int half = d >= 160, i = d - 128 - 32 * half;
    return 1024 + (h >> 2) * 256 + half * 128 + (h & 3) * 32 + i;
}
__device__ __forceinline__ void transpose_item(const float* W, int K, int N, bf16* WT, int row_off, int mode, LAS float* scr, int item, int lane) {
    const int nblk = N / 32, kb = item / nblk, nb = item % nblk, k0 = 64 * kb, n0 = 32 * nb;
#pragma unroll 8
    for (int i = 0; i < 32; ++i) { const int kk = 2 * i + (lane >> 5); scr[kk * 33 + (lane & 31)] = W[(size_t)(k0 + kk) * N + n0 + (lane & 31)]; }
    LDS_WAIT(); asm volatile("" ::: "memory");
    const int c = lane & 7, r0 = row_off + map_row(mode, n0);
#pragma unroll
    for (int j = 0; j < 4; ++j) { const int n = (lane >> 3) + 8 * j; const LAS float* s = scr + (8 * c) * 33 + n;
        v4u o; o.x = pk2(s[0 * 33], s[1 * 33]); o.y = pk2(s[2 * 33], s[3 * 33]); o.z = pk2(s[4 * 33], s[5 * 33]); o.w = pk2(s[6 * 33], s[7 * 33]);
        *(v4u*)(WT + (size_t)(r0 + n) * K + k0 + 8 * c) = o; }
    LDS_WAIT(); asm volatile("" ::: "memory");
}
__device__ __forceinline__ void ln_row(float* row, bf16* orow, const float* g, const float* b, int lane) {
    f32x4* xr = (f32x4*)row + lane;
    f32x4 v[4]; float s = 0.f;
#pragma unroll
    for (int j = 0; j < 4; ++j) { v[j] = xr[64 * j]; s += (v[j].x + v[j].y) + (v[j].z + v[j].w); }
    const float mean = wave_sum(s) * (1.f / D); float s2 = 0.f;
#pragma unroll
    for (int j = 0; j < 4; ++j) { v[j] = v[j] - mean; s2 += (v[j].x * v[j].x + v[j].y * v[j].y) + (v[j].z * v[j].z + v[j].w * v[j].w); }
    const float rstd = 1.f / sqrtf(wave_sum(s2) * (1.f / D) + LN_EPS);
#pragma unroll
    for (int j = 0; j < 4; ++j) { const f32x4 gg = *((const f32x4*)g + lane + 64 * j), bb = *((const f32x4*)b + lane + 64 * j);
        const f32x4 y = v[j] * rstd * gg + bb; xr[64 * j] = y;
        if (orow) { v2u w; w.x = pk2(y.x, y.y); w.y = pk2(y.z, y.w); *((v2u*)orow + lane + 64 * j) = w; } }
}

__global__ void __launch_bounds__(NWAVES * 64, 2) mega_fwd(Args args) {
    extern __shared__ __attribute__((aligned(16))) unsigned char lds[];
    cg::grid_group grid = cg::this_grid();
    LAS unsigned char* ldsl = (LAS unsigned char*)lds;
    const int tid = threadIdx.x, lane0 = tid & 63, wave = __builtin_amdgcn_readfirstlane(tid >> 6);
    const int G = gridDim.x, bx = blockIdx.x;
    const int vcu = (G % 8 == 0) ? (bx % 8) * (G / 8) + bx / 8 : bx;
    const int gw = vcu * NWAVES + wave, NGW = G * NWAVES;
    volatile LAS unsigned* MISC = (volatile LAS unsigned*)(ldsl + MISC_OFF);
    if (tid < 16) MISC[tid] = 0u;
    if (tid == 0) {
        volatile LAS unsigned long long* A = (volatile LAS unsigned long long*)(MISC + 16);
#pragma unroll
        for (int i = 0; i < 25; ++i) A[i] = (unsigned long long)args.in[i];
        A[25] = (unsigned long long)args.out; A[26] = (unsigned long long)args.ws;
    }
    if (bx == 0) { unsigned* barw0 = (unsigned*)args.ws; for (int i = tid; i < XCD_BAR_WORDS; i += NWAVES * 64) __hip_atomic_store(barw0 + i, 0u, __ATOMIC_RELAXED, __HIP_MEMORY_SCOPE_AGENT); }
    __syncthreads();
#define ARGF(i) ((const float*)argp(MISC, (i)))
#define WSP(T, off) ((T*)((unsigned char*)argp(MISC, 26) + (off)))
#define x_in ARGF(0)
#define positions ((const int*)argp(MISC, 1))
#define ln_mix_g ARGF(2)
#define ln_mix_b ARGF(3)
#define ln_ffn_g ARGF(4)
#define ln_ffn_b ARGF(5)
#define w_ff1 ARGF(6)
#define w_ff2 ARGF(7)
#define lam_re ARGF(8)
#define lam_im ARGF(9)
#define log_dt ARGF(10)
#define b_re ARGF(11)
#define b_im ARGF(12)
#define c_re ARGF(13)
#define c_im ARGF(14)
#define ssm_d ARGF(15)
#define w_glu ARGF(16)
#define w_out ARGF(17)
#define kv_w_a ARGF(18)
#define kv_norm_g ARGF(19)
#define kv_w_b ARGF(20)
#define q_w_a ARGF(21)
#define q_norm_g ARGF(22)
#define q_w_b ARGF(23)
#define attn_w_o ARGF(24)
#define R ((float*)argp(MISC, 25))
#define Wglu_t WSP(bf16, WS_WGLU)
#define Wout_t WSP(bf16, WS_WOUT)
#define W1_t WSP(bf16, WS_W1)
#define W2_t WSP(bf16, WS_W2)
#define Wqkva_t WSP(bf16, WS_WQKVA)
#define Wkvb_t WSP(bf16, WS_WKVB)
#define Wqb_t WSP(bf16, WS_WQB)
#define Wo_t WSP(bf16, WS_WO)
#define W1g WSP(bf16, WS_W1G)
#define Tg WSP(bf16, WS_TG)
#define Kbuf WSP(float, WS_KBUF)
#define AL WSP(float, WS_AL)
#define Xg WSP(bf16, WS_XG)
#define Ebuf WSP(float, WS_E)
#define Yact WSP(bf16, WS_YACT)
#define Gb WSP(bf16, WS_G)
#define Hb WSP(bf16, WS_HB)
#define HID WSP(bf16, WS_HID)
#define CQKV WSP(float, WS_CQKV)
#define CKV WSP(bf16, WS_CKV)
#define CQ WSP(bf16, WS_CQ)
#define KR WSP(bf16, WS_KR)
#define CS WSP(float, WS_CS)
#define KV WSP(bf16, WS_KV)
#define Qb WSP(bf16, WS_Q)
#define Ob WSP(bf16, WS_O)

    {
        const int lane = launder(lane0);
        LAS float* scr = (LAS float*)(ldsl + wave * 16384);
        constexpr int I_GLU = 16 * 64, I_OUT = 16 * 32, I_F1 = 16 * 128, I_F2 = 64 * 32, I_KVA = 16 * 10, I_QA = 16 * 12, I_KVB = 4 * 64, I_QB = 6 * 48, I_WO = 16 * 32;
        constexpr int NT_ITEMS = I_GLU + I_OUT + 2 * I_F1 + 2 * I_F2 + I_KVA + I_QA + I_KVB + I_QB + I_WO;
        for (int it = gw; it < NT_ITEMS; it += NGW) {
            int r = it;
            if (r < I_GLU) { transpose_item(w_glu, 1024, 2048, Wglu_t, 0, 1, scr, r, lane); continue; } r -= I_GLU;
            if (r < I_OUT) { transpose_item(w_out, 1024, 1024, Wout_t, 0, 0, scr, r, lane); continue; } r -= I_OUT;
            if (r < I_F1) { transpose_item(w_ff1, 1024, 4096, W1_t, 0, 0, scr, r, lane); continue; } r -= I_F1;
            if (r < I_F1) { transpose_item(w_ff1 + (size_t)1024 * 4096, 1024, 4096, W1_t + (size_t)4096 * 1024, 0, 0, scr, r, lane); continue; } r -= I_F1;
            if (r < I_F2) { transpose_item(w_ff2, 4096, 1024, W2_t, 0, 0, scr, r, lane); continue; } r -= I_F2;
            if (r < I_F2) { transpose_item(w_ff2 + (size_t)4096 * 1024, 4096, 1024, W2_t + (size_t)1024 * 4096, 0, 0, scr, r, lane); continue; } r -= I_F2;
            if (r < I_KVA) { transpose_item(kv_w_a, 1024, 320, Wqkva_t, 0, 0, scr, r, lane); continue; } r -= I_KVA;
            if (r < I_QA) { transpose_item(q_w_a, 1024, 384, Wqkva_t, 320, 0, scr, r, lane); continue; } r -= I_QA;
            if (r < I_KVB) { transpose_item(kv_w_b, 256, 2048, Wkvb_t, 0, 0, scr, r, lane); continue; } r -= I_KVB;
            if (r < I_QB) { transpose_item(q_w_b, 384, 1536, Wqb_t, 0, 2, scr, r, lane); continue; } r -= I_QB;
            transpose_item(attn_w_o, 1024, 1024, Wo_t, 0, 0, scr, r, lane);
        }
        for (int i = gw * 64 + lane; i < 8192; i += NGW * 64) { *((v4u*)(Wqkva_t + (size_t)704 * 1024) + i) = (v4u){0u, 0u, 0u, 0u}; *((v4u*)(W1g + (size_t)NG * 128 * 512) + i) = (v4u){0u, 0u, 0u, 0u}; }
        for (int it = gw; it < 4096 + 2048 + 2048 + 64; it += NGW) {
            if (it < 4096) {
                const int g = it >> 6, p = it & 63;
                const float lr = lam_re[g * 64 + p], li = lam_im[g * 64 + p], dt = expf(log_dt[g]), lrdt = lr * dt, lidt = li * dt;
                float are, aim; cpow_a(lrdt, lidt, 1.f, are, aim);
                const float inv = 1.0f / (lr * lr + li * li), cre = ((are - 1.0f) * lr + aim * li) * inv, cim = (aim * lr - (are - 1.0f) * li) * inv;
                const int c = lane & 15;
                const float br = b_re[(size_t)(g * 64 + p) * 16 + c], bi = b_im[(size_t)(g * 64 + p) * 16 + c];
                const float bbre = cre * br - cim * bi, bbim = cre * bi + cim * br;
#pragma unroll
                for (int i = 0; i < 8; ++i) { const int s = (lane >> 4) + 4 * i; float pr, pi; cpow_a(lrdt, lidt, (float)(31 - s), pr, pi);
                    W1g[(size_t)(g * 128 + p) * 512 + s * 16 + c] = (bf16)f2bf(pr * bbre - pi * bbim);
                    W1g[(size_t)(g * 128 + 64 + p) * 512 + s * 16 + c] = (bf16)f2bf(pr * bbim + pi * bbre); }
            } else if (it < 4096 + 2048) {
                const int r = it - 4096, g = r >> 5, j = r & 31;
                LAS float* sbr = scr; LAS float* sbi = scr + 1024; LAS float* scre = scr + 2048; LAS float* scim = scr + 3072;
#pragma unroll
                for (int q = 0; q < 4; ++q) { const int idx = (q * 64 + lane) * 4;
                    *(LAS f32x4*)(sbr + idx) = *(const f32x4*)(b_re + (size_t)g * 1024 + idx); *(LAS f32x4*)(sbi + idx) = *(const f32x4*)(b_im + (size_t)g * 1024 + idx);
                    *(LAS f32x4*)(scre + idx) = *(const f32x4*)(c_re + (size_t)g * 1024 + idx); *(LAS f32x4*)(scim + idx) = *(const f32x4*)(c_im + (size_t)g * 1024 + idx); }
                const int p = lane;
                const float lr = lam_re[g * 64 + p], li = lam_im[g * 64 + p], dt = expf(log_dt[g]), lrdt = lr * dt, lidt = li * dt;
                float are, aim; cpow_a(lrdt, lidt, 1.f, are, aim);
                const float inv = 1.0f / (lr * lr + li * li), cre = ((are - 1.0f) * lr + aim * li) * inv, cim = (aim * lr - (are - 1.0f) * li) * inv;
                float pr, pi; cpow_a(lrdt, lidt, (float)j, pr, pi);
                const float zre = pr * cre - pi * cim, zim = pr * cim + pi * cre;
                LDS_WAIT(); asm volatile("" ::: "memory");
                const int ci = lane & 15, cog = lane >> 4;
                float acc4[4] = {0.f, 0.f, 0.f, 0.f};
                for (int pp = 0; pp < 64; ++pp) {
                    const float zr = __shfl(zre, pp), zi = __shfl(zim, pp), br = sbr[pp * 16 + ci], bi = sbi[pp * 16 + ci];
                    const float xr = zr * br - zi * bi, xi = zr * bi + zi * br;
#pragma unroll
                    for (int k = 0; k < 4; ++k) acc4[k] += scre[(cog + 4 * k) * 64 + pp] * xr - scim[(cog + 4 * k) * 64 + pp] * xi;
                }
#pragma unroll
                for (int k = 0; k < 4; ++k) { const int co = cog + 4 * k; float v = acc4[k]; if (j == 0 && co == ci) v += ssm_d[g * 16 + co];
                    Kbuf[((size_t)(g * 32 + j) * 16 + co) * 16 + ci] = v; }
                LDS_WAIT(); asm volatile("" ::: "memory");
            } else if (it < 4096 + 4096) {
                const int r = it - 6144, g = r >> 5, t = r & 31, p = lane;
                const float lr = lam_re[g * 64 + p], li = lam_im[g * 64 + p], dt = expf(log_dt[g]);
                float pr, pi; cpow_a(lr * dt, li * dt, (float)(t + 1), pr, pi);
#pragma unroll 4
                for (int co = 0; co < 16; ++co) { const float cr = c_re[(size_t)(g * 16 + co) * 64 + p], cim_ = c_im[(size_t)(g * 16 + co) * 64 + p];
                    bf16* rowp = Tg + (size_t)(g * 512 + t * 16 + co) * XG_LD + 512;
                    rowp[p] = (bf16)f2bf(cr * pr - cim_ * pi); rowp[64 + p] = (bf16)f2bf(-(cr * pi + cim_ * pr)); }
            } else {
                const int g = it - 8192, p = lane;
                const float lr = lam_re[g * 64 + p], li = lam_im[g * 64 + p], dt = expf(log_dt[g]);
                float pr, pi; cpow_a(lr * dt, li * dt, 32.f, pr, pi);
                AL[(g * 64 + p) * 2] = pr; AL[(g * 64 + p) * 2 + 1] = pi;
            }
        }
        for (int tok = gw; tok < M; tok += NGW) {
            const f32x4* src = (const f32x4*)(x_in + (size_t)tok * D + lane * 16);
            const f32x4 v0 = src[0], v1 = src[1], v2 = src[2], v3 = src[3];
            v4u o0, o1; o0.x = pk2(v0.x, v0.y); o0.y = pk2(v0.z, v0.w); o0.z = pk2(v1.x, v1.y); o0.w = pk2(v1.z, v1.w);
            o1.x = pk2(v2.x, v2.y); o1.y = pk2(v2.z, v2.w); o1.z = pk2(v3.x, v3.y); o1.w = pk2(v3.z, v3.w);
            v4u* dst = (v4u*)(Xg + ((size_t)lane * RPG + (tok >> 5)) * XG_LD + (tok & 31) * 16);
            dst[0] = o0; dst[1] = o1;
        }
    }
    grid.sync();
    { const XcdBarrier xb0 = xcd_barrier_post((unsigned*)argp(MISC, 26), MISC + 8); if (tid == 0) MISC[10] = xb0.x; }
    {
        pg8::Gemm g{Xg, W1g, 512, XG_LD, 512, (unsigned)(256 * XG_LD * 2), (unsigned)(128 * 512 * 2)};
        pg8::BatchOrder S; S.init(NG, 4, 1, G, bx);
        pg8::EpiS1 E{Ebuf};
        pg8::gemm_phase<pg8::EpiS1, pg8::BatchOrder, true>(ldsl, g, S, E);
        const int lane = launder(lane0);
        for (int it = gw; it < 2048; it += NGW) {
            const int g_ = it >> 5, t = it & 31, ci = lane & 15;
            for (int co = 0; co < 16; ++co) {
                bf16* rowp = Tg + (size_t)(g_ * 512 + t * 16 + co) * XG_LD;
#pragma unroll
                for (int i = 0; i < 8; ++i) { const int s = (lane >> 4) + 4 * i;
                    const float v = s <= t ? Kbuf[((size_t)(g_ * 32 + (t - s)) * 16 + co) * 16 + ci] : 0.f;
                    rowp[s * 16 + ci] = (bf16)f2bf(v); }
            }
        }
    }
    xcd_barrier(MISC);
    if (wave < 2) {
        const int item = bx * 2 + wave;
        if (item < NG * BATCH) {
            const int g_ = item >> 3, b = item & 7, p = launder(lane0);
            const float ar = AL[(g_ * 64 + p) * 2], ai = AL[(g_ * 64 + p) * 2 + 1];
            float hr = 0.f, hi = 0.f;
            const float* Ep = Ebuf + ((size_t)g_ * RPG + b * NCH) * 128 + p;
            bf16* Hp = Xg + ((size_t)g_ * RPG + b * NCH) * XG_LD + 512 + p;
            for (int c0 = 0; c0 < NCH; c0 += 8) {
                float er[8], ei[8];
#pragma unroll
                for (int k = 0; k < 8; ++k) { er[k] = Ep[(size_t)(c0 + k) * 128]; ei[k] = Ep[(size_t)(c0 + k) * 128 + 64]; }
#pragma unroll
                for (int k = 0; k < 8; ++k) { Hp[(size_t)(c0 + k) * XG_LD] = (bf16)f2bf(hr); Hp[(size_t)(c0 + k) * XG_LD + 64] = (bf16)f2bf(hi);
                    const float nr = ar * hr - ai * hi + er[k], ni = ar * hi + ai * hr + ei[k]; hr = nr; hi = ni; }
            }
        }
    }
    xcd_barrier(MISC);
    {
        pg8::Gemm g{Xg, Tg, XG_LD, XG_LD, XG_LD, (unsigned)(256 * XG_LD * 2), (unsigned)(256 * XG_LD * 2)};
        pg8::BatchOrder S; S.init(NG, 4, 2, G, bx);
        pg8::EpiS3 E{Yact};
        pg8::gemm_phase<pg8::EpiS3, pg8::BatchOrder, true>(ldsl, g, S, E);
    }
    xcd_barrier(MISC);
    {
        pg8::Gemm g{Yact, Wglu_t, 1024, 1024, 1024, (unsigned)(256 * 1024 * 2), (unsigned)(256 * 1024 * 2)};
        pg8::StaticOrder S; S.init(M, 2048, G, bx);
        pg8::EpiGlu E{Gb, 1024};
        pg8::gemm_phase<pg8::EpiGlu, pg8::StaticOrder, true>(ldsl, g, S, E);
    }
    xcd_barrier(MISC);
    {
        pg8::Gemm g{Gb, Wout_t, 1024, 1024, 1024, (unsigned)(256 * 1024 * 2), (unsigned)(256 * 1024 * 2)};
        pg8::StaticOrder S; S.init(M, 1024, G, bx);
        pg8::EpiRes E{x_in, R, 1024, DN_ALPHA};
        pg8::gemm_phase<pg8::EpiRes, pg8::StaticOrder, true>(ldsl, g, S, E);
    }
    xcd_barrier(MISC);
#pragma unroll
    for (int layer = 0; layer < 2; ++layer) {
        if (layer == 1) {
            {
                pg8::Gemm g{Hb, Wqkva_t, 1024, 1024, 1024, (unsigned)(256 * 1024 * 2), (unsigned)(256 * 1024 * 2)};
                pg8::StaticOrder S; S.init(M, 768, G, bx);
                pg8::EpiF32 E{CQKV, 768};
                pg8::gemm_phase<pg8::EpiF32, pg8::StaticOrder, true>(ldsl, g, S, E);
            }
            xcd_barrier(MISC);
            const int lane = launder(lane0);
            for (int tok = gw; tok < M; tok += NGW) {
                const float* row = CQKV + (size_t)tok * 768;
                const f32x4 kv = *((const f32x4*)row + lane);
                const f32x2 q0 = *((const f32x2*)(row + 320) + lane * 3), q1 = *((const f32x2*)(row + 320) + lane * 3 + 1), q2 = *((const f32x2*)(row + 320) + lane * 3 + 2);
                const float skv = wave_sum(kv.x * kv.x + kv.y * kv.y + kv.z * kv.z + kv.w * kv.w);
                const float sq = wave_sum(q0.x * q0.x + q0.y * q0.y + q1.x * q1.x + q1.y * q1.y + q2.x * q2.x + q2.y * q2.y);
                const float rkv = 1.0f / sqrtf(skv * (1.0f / 256.0f) + RMS_EPS), rq = 1.0f / sqrtf(sq * (1.0f / 384.0f) + RMS_EPS);
                const f32x4 gk = *((const f32x4*)kv_norm_g + lane);
                v2u wkv; wkv.x = pk2(kv.x * rkv * gk.x, kv.y * rkv * gk.y); wkv.y = pk2(kv.z * rkv * gk.z, kv.w * rkv * gk.w);
                *((v2u*)(CKV + (size_t)tok * 256) + lane) = wkv;
                const float* gq = q_norm_g + lane * 6;
                unsigned* qo = (unsigned*)(CQ + (size_t)tok * 384) + lane * 3;
                qo[0] = pk2(q0.x * rq * gq[0], q0.y * rq * gq[1]); qo[1] = pk2(q1.x * rq * gq[2], q1.y * rq * gq[3]); qo[2] = pk2(q2.x * rq * gq[4], q2.y * rq * gq[5]);
                if (lane < 32) {
                    const float pos = (float)positions[tok];
                    const float invf = exp2f(-(float)lane * (13.287712379549449f / 32.0f));
                    float sn, cs; sincos_red(pos * invf, sn, cs);
                    CS[(size_t)tok * 64 + lane] = cs; CS[(size_t)tok * 64 + 32 + lane] = sn;
                    const float x1 = row[256 + lane], x2 = row[288 + lane];
                    KR[(size_t)tok * 64 + lane] = (bf16)f2bf(x1 * cs - x2 * sn); KR[(size_t)tok * 64 + 32 + lane] = (bf16)f2bf(x1 * sn + x2 * cs);
                }
            }
            xcd_barrier(MISC);
            {
                pg8::Gemm g{CKV, Wkvb_t, 256, 256, 256, (unsigned)(256 * 256 * 2), (unsigned)(256 * 256 * 2)};
                pg8::StaticOrder S; S.init(M, 2048, G, bx);
                pg8::EpiBf16<0> E{KV, 2048, 128};
                pg8::gemm_phase<pg8::EpiBf16<0>, pg8::StaticOrder, true>(ldsl, g, S, E);
            }
            {
                pg8::Gemm g{CQ, Wqb_t, 384, 384, 384, (unsigned)(256 * 384 * 2), (unsigned)(256 * 384 * 2)};
                pg8::StaticOrder S; S.init(M, 1024, G, bx);
                pg8::EpiBf16<0> E{Qb, 1536, 192};
                pg8::gemm_phase<pg8::EpiBf16<0>, pg8::StaticOrder, true>(ldsl, g, S, E);
            }
            {
                pg8::Gemm g{CQ, Wqb_t + (size_t)1024 * 384, 384, 384, 384, (unsigned)(256 * 384 * 2), (unsigned)(256 * 384 * 2)};
                pg8::StaticOrder S; S.init(M, 512, G, bx);
                pg8::EpiQ E{Qb, CS};
                pg8::gemm_phase<pg8::EpiQ, pg8::StaticOrder, true>(ldsl, g, S, E);
            }
            xcd_barrier(MISC);
            {
                const att::Tensors T{(const att::bf16*)Qb, (const att::bf16*)KV, (const att::bf16*)KR, (att::bf16*)Ob};
#pragma nounroll
                for (int rep_ = 0; rep_ < (PROBE == 1 ? 2 : 1); ++rep_) { if (rep_) xcd_barrier(MISC); att::attn_phase((char*)lds, T, G, vcu); }
            }
            xcd_barrier(MISC);
#if PROBE == 2
            for (int i_ = 0; i_ < 20; ++i_) xcd_barrier(MISC);
#endif
            {
                pg8::Gemm g{Ob, Wo_t, 1024, 1024, 1024, (unsigned)(256 * 1024 * 2), (unsigned)(256 * 1024 * 2)};
                pg8::StaticOrder S; S.init(M, 1024, G, bx);
                pg8::EpiRes E{R, R, 1024, DN_ALPHA};
                pg8::gemm_phase<pg8::EpiRes, pg8::StaticOrder, true>(ldsl, g, S, E);
            }
            xcd_barrier(MISC);
        }
        { const int lane = launder(lane0); for (int m = gw; m < M; m += NGW) ln_row(R + (size_t)m * D, Hb + (size_t)m * D, ln_mix_g + layer * D, ln_mix_b + layer * D, lane); }
        xcd_barrier(MISC);
        {
            pg8::Gemm g{Hb, W1_t + (size_t)layer * 4096 * 1024, 1024, 1024, 1024, (unsigned)(256 * 1024 * 2), (unsigned)(256 * 1024 * 2)};
            pg8::StaticOrder S; S.init(M, 4096, G, bx);
            pg8::EpiBf16<1> E{HID, 4096, 128};
#pragma nounroll
            for (int rep_ = 0; rep_ < (PROBE == 3 ? 2 : 1); ++rep_) { if (rep_) xcd_barrier(MISC); pg8::gemm_phase<pg8::EpiBf16<1>, pg8::StaticOrder, true>(ldsl, g, S, E); }
        }
        xcd_barrier(MISC);
        {
            pg8::Gemm g{HID, W2_t + (size_t)layer * 1024 * 4096, 4096, 4096, 4096, (unsigned)(256 * 4096 * 2), (unsigned)(256 * 4096 * 2)};
            pg8::StaticOrder S; S.init(M, 1024, G, bx);
            pg8::EpiRes E{R, R, 1024, DN_ALPHA};
            pg8::gemm_phase<pg8::EpiRes, pg8::StaticOrder, true>(ldsl, g, S, E);
        }
        xcd_barrier(MISC);
        { const int lane = launder(lane0); for (int m = gw; m < M; m += NGW) ln_row(R + (size_t)m * D, layer == 0 ? Hb + (size_t)m * D : (bf16*)nullptr, ln_ffn_g + layer * D, ln_ffn_b + layer * D, lane); }
        if (layer == 0) xcd_barrier(MISC);
    }
}

#undef ARGF
#undef WSP
#undef x_in
#undef positions
#undef ln_mix_g
#undef ln_mix_b
#undef ln_ffn_g
#undef ln_ffn_b
#undef w_ff1
#undef w_ff2
#undef lam_re
#undef lam_im
#undef log_dt
#undef b_re
#undef b_im
#undef c_re
#undef c_im
#undef ssm_d
#undef w_glu
#undef w_out
#undef kv_w_a
#undef kv_norm_g
#undef kv_w_b
#undef q_w_a
#undef q_norm_g
#undef q_w_b
#undef attn_w_o
#undef R
#undef Wglu_t
#undef Wout_t
#undef W1_t
#undef W2_t
#undef Wqkva_t
#undef Wkvb_t
#undef Wqb_t
#undef Wo_t
#undef W1g
#undef Tg
#undef Kbuf
#undef AL
#undef Xg
#undef Ebuf
#undef Yact
#undef Gb
#undef Hb
#undef HID
#undef CQKV
#undef CKV
#undef CQ
#undef KR
#undef CS
#undef KV
#undef Qb
#undef Ob
extern "C" void kernel_launch(void* const* d_in, const int* in_sizes, int n_in, void* d_out, int out_size, void* d_ws, size_t ws_size, hipStream_t stream) {
    static int grid = 0;
    if (grid == 0) {
        if (n_in != 25 || in_sizes[0] != M * D || out_size != M * D || ws_size < WS_END) { fprintf(stderr, "kernel_launch: unexpected shapes (n_in %d, in0 %d, out %d, ws %zu)\n", n_in, n_in > 0 ? in_sizes[0] : -1, out_size, ws_size); grid = -1; return; }
        int dev = 0, cus = 0, per_cu = 0;
        if (hipGetDevice(&dev) != hipSuccess || hipDeviceGetAttribute(&cus, hipDeviceAttributeMultiprocessorCount, dev) != hipSuccess) { grid = -1; return; }
        if (hipFuncSetAttribute((const void*)mega_fwd, hipFuncAttributeMaxDynamicSharedMemorySize, LDS_BYTES) != hipSuccess) { fprintf(stderr, "kernel_launch: hipFuncSetAttribute failed\n"); grid = -1; return; }
        if (hipOccupancyMaxActiveBlocksPerMultiprocessor(&per_cu, (const void*)mega_fwd, NWAVES * 64, LDS_BYTES) != hipSuccess || per_cu < 1) per_cu = 1;
        (void)hipGetLastError();
        grid = cus;
    }
    if (grid < 0) return;
    Args a{};
    for (int i = 0; i < 25; ++i) a.in[i] = d_in[i];
    a.out = (float*)d_out; a.ws = (unsigned char*)d_ws;
    void* kargs[] = {&a};
    hipError_t e = hipLaunchCooperativeKernel((const void*)mega_fwd, dim3(grid), dim3(NWAVES * 64), kargs, LDS_BYTES, stream);
    if (e != hipSuccess) fprintf(stderr, "kernel_launch: cooperative launch failed: %s (grid %d)\n", hipGetErrorString(e), grid);
}
```

```cpp
#include <hip/hip_runtime.h>
#include <hip/hip_bf16.h>
#include <hip/hip_cooperative_groups.h>
#include <cstdio>
#include <cstdint>
namespace cg = cooperative_groups;
#ifndef PROBE
#define PROBE 0
#endif
#define PROBE_MASK 0u
#define PROBE_HI (PROBE_MASK != 0u)
#define PROBE_MULT 4
__device__ __forceinline__ int lane_id() { int l; asm volatile("v_mbcnt_lo_u32_b32 %0, -1, 0\n\tv_mbcnt_hi_u32_b32 %0, -1, %0" : "=v"(l)); return l; }

namespace pg8 {
#define PG8_LAS __attribute__((address_space(3)))
typedef unsigned short bf16_t;
typedef short bf16x8 __attribute__((ext_vector_type(8)));
typedef float f32x4 __attribute__((ext_vector_type(4)));
typedef float f32x2 __attribute__((ext_vector_type(2)));
typedef unsigned u32x4 __attribute__((ext_vector_type(4)));
constexpr int BM = 256, BK = 64, HALF = 128, HTB = HALF * BK * 2, STAGE_BYTES = 8 * HTB, NXCD = 8, WGM = 8;

__host__ __device__ __forceinline__ int lds_byte(int r, int c) { const int st = (r >> 4) * 2 + (c >> 5), rr = r & 15, cc = c & 31, ob = rr * 64 + cc * 2; return st * 1024 + (ob ^ (((ob >> 9) & 1) << 5)); }
__host__ __device__ __forceinline__ void stage_rc(int b, int& R, int& C) { const int st = b / 1024, sb = b % 1024, swz = sb ^ (((sb >> 9) & 1) << 5); R = (st >> 1) * 16 + swz / 64; C = (st & 1) * 32 + (swz % 64) / 2; }
__host__ __device__ __forceinline__ int perm32(int rho) { const int n = rho >> 4, i = rho & 15; return 8 * (i >> 2) + 4 * n + (i & 3); }

struct Unit { int pm, pn; };
struct Gemm { const bf16_t* A; const bf16_t* Bt; int K, lda, ldb; unsigned tstepA, tstepB; unsigned agstride = 0; };

struct StaticOrder {
    int nM, nN, nwg, G, c, pm0;
    __device__ void init(int M, int N, int G_, int c_, int pm0_ = 0) { nM = M / BM; nN = N / BM; nwg = nM * nN; G = G_; c = c_; pm0 = pm0_; }
    __device__ bool next(int i, Unit& u) const {
        const long L = (long)i * G + c; if (L >= nwg) return false;
        int wgid = (int)L; { const int q = nwg / NXCD, r = nwg % NXCD, xcd = wgid % NXCD, off = wgid / NXCD; wgid = (xcd < r ? xcd * (q + 1) : r * (q + 1) + (xcd - r) * q) + off; }
        const int nig = WGM * nN, gid = wgid / nig, fm = gid * WGM, gsz = (nM - fm) < WGM ? (nM - fm) : WGM;
        u.pm = pm0 + fm + ((wgid % nig) % gsz); u.pn = (wgid % nig) / gsz; return true;
    }
};
struct BatchOrder {
    int nwg, G, c, mper, nper;
    __device__ void init(int ngroups, int mper_, int nper_, int G_, int c_) { mper = mper_; nper = nper_; nwg = ngroups * mper_ * nper_; G = G_; c = c_; }
    __device__ bool next(int i, Unit& u) const {
        const int L = i * G + c; if (L >= nwg) return false;
        const int per = mper * nper, g = L / per, r = L % per;
        u.pm = g * mper + r / nper; u.pn = g * nper + r % nper; return true;
    }
};

__device__ __forceinline__ unsigned cvt_pk_bf16(float lo, float hi) { unsigned r; asm volatile("v_cvt_pk_bf16_f32 %0, %1, %2" : "=v"(r) : "v"(lo), "v"(hi)); return r; }

typedef f32x4 Acc[2][2][4][2];

#ifndef PG8_SP2
#define PG8_SP2 true
#endif
template <class Epi, class Sched, bool ALIGN_EPI, bool SP2 = PG8_SP2>
__device__ __forceinline__ void gemm_phase(PG8_LAS unsigned char* lds, const Gemm g, const Sched& S, const Epi& E, int wave_id) {
    int tid_ = (wave_id << 6) | lane_id(); asm volatile("" : "+v"(tid_));
    const int tid = tid_, wid = __builtin_amdgcn_readfirstlane(tid >> 6), lane = tid & 63, wr = wid >> 2, wc = wid & 3, fr = lane & 15, fq = lane >> 4;
    const int K = g.K, nt = K / BK;
    unsigned voffA[2], voffB[2];
#pragma unroll
    for (int i = 0; i < 2; ++i) { int R, C; stage_rc(tid * 16 + i * 8192, R, C); const int Rb = Epi::PERM ? ((R & ~31) + perm32(R & 31)) : R;
        voffA[i] = g.agstride ? ((unsigned)(C >> 4) * g.agstride + (unsigned)(R * 16 + (C & 15))) * 2u : (unsigned)(R * g.lda + C) * 2u; voffB[i] = (unsigned)(Rb * g.ldb + C) * 2u; }
    const size_t kstep = (size_t)(BK * 2), kstepA = g.agstride ? (size_t)g.agstride * 8 : kstep;
    const size_t hstepA = g.agstride ? (size_t)HALF * 32 : (size_t)HALF * g.lda * 2, hstepB = (size_t)HALF * g.ldb * 2;
    const unsigned ldsw = (unsigned)wid * 1024u;
    const int aoff = lds_byte(wr * 64 + fr, fq * 8), boff = lds_byte(wc * 32 + fr, fq * 8);
#define PG8_SA(b, h) (((b) * 2 + (h)) * HTB)
#define PG8_SB(b, h) ((4 + (b) * 2 + (h)) * HTB)
#define PG8_STAGE(bufoff, gbase, voff) do { _Pragma("unroll") for (int _i = 0; _i < 2; ++_i) \
        __builtin_amdgcn_global_load_lds((const unsigned*)((const char*)(gbase) + (voff)[_i]), (PG8_LAS unsigned*)(lds + (bufoff) + ldsw + _i * 8192), 16, 0, 0); } while (0)
#define PG8_LDA(dst, b, h) do { _Pragma("unroll") for (int m = 0; m < 4; ++m) _Pragma("unroll") for (int k = 0; k < 2; ++k) dst[m][k] = *(const PG8_LAS bf16x8*)(lds + PG8_SA(b, h) + aoff + m * 2048 + k * 1024); } while (0)
#define PG8_LDB(dst, b, h) do { _Pragma("unroll") for (int n = 0; n < 2; ++n) _Pragma("unroll") for (int k = 0; k < 2; ++k) dst[n][k] = *(const PG8_LAS bf16x8*)(lds + PG8_SB(b, h) + boff + n * 2048 + k * 1024); } while (0)
#define PG8_MMA(ai, bj, At, Bt) do { __builtin_amdgcn_s_setprio(1); _Pragma("unroll") for (int m = 0; m < 4; ++m) _Pragma("unroll") for (int n = 0; n < 2; ++n) _Pragma("unroll") for (int k = 0; k < 2; ++k) \
        acc[ai][bj][m][n] = __builtin_amdgcn_mfma_f32_16x16x32_bf16(Bt[n][k], At[m][k], acc[ai][bj][m][n], 0, 0, 0); __builtin_amdgcn_s_setprio(0); } while (0)
#define PG8_WAIT_V(n) asm volatile("s_waitcnt vmcnt(" #n ")" ::: "memory")
#define PG8_WAIT_L(n) asm volatile("s_waitcnt lgkmcnt(" #n ")" ::: "memory")
#define PG8_BAR __builtin_amdgcn_s_barrier()
#define PG8_SCHED __builtin_amdgcn_sched_barrier(0)
    Unit cur, nxt; int ui = 0;
    if (!S.next(0, cur)) return;
    Acc acc;
#pragma unroll
    for (int a = 0; a < 2; ++a)
#pragma unroll
        for (int b = 0; b < 2; ++b)
#pragma unroll
            for (int m = 0; m < 4; ++m)
#pragma unroll
                for (int n = 0; n < 2; ++n) acc[a][b][m][n] = (f32x4){0.f, 0.f, 0.f, 0.f};
    bf16x8 At[4][2], B0[2][2], B1[2][2];
    const char* cA = (const char*)g.A + (size_t)cur.pm * g.tstepA; const char* cB = (const char*)g.Bt + (size_t)cur.pn * g.tstepB;
    if constexpr (SP2) {
    PG8_STAGE(PG8_SB(0, 0), cB, voffB); PG8_STAGE(PG8_SB(0, 1), cB + hstepB, voffB); PG8_STAGE(PG8_SA(0, 0), cA, voffA); PG8_STAGE(PG8_SA(0, 1), cA + hstepA, voffA);
    if (wr == 1) PG8_BAR;
    PG8_WAIT_V(2); PG8_BAR;
    PG8_STAGE(PG8_SB(1, 0), cB + kstep, voffB); PG8_STAGE(PG8_SA(1, 0), cA + kstepA, voffA); PG8_STAGE(PG8_SB(1, 1), cB + hstepB + kstep, voffB);
    PG8_WAIT_V(6); PG8_BAR;
    } else {
    PG8_STAGE(PG8_SB(0, 0), cB, voffB); PG8_STAGE(PG8_SA(0, 0), cA, voffA); PG8_STAGE(PG8_SB(0, 1), cB + hstepB, voffB); PG8_STAGE(PG8_SA(0, 1), cA + hstepA, voffA);
    if (wr == 1) PG8_BAR;
    PG8_WAIT_V(4); PG8_BAR;
    PG8_STAGE(PG8_SB(1, 0), cB + kstep, voffB); PG8_STAGE(PG8_SA(1, 0), cA + kstepA, voffA); PG8_STAGE(PG8_SB(1, 1), cB + hstepB + kstep, voffB);
    PG8_WAIT_V(6); PG8_BAR;
    }
    for (;;) {
        const bool has_next = S.next(ui + 1, nxt);
        const char* nA = has_next ? (const char*)g.A + (size_t)nxt.pm * g.tstepA : cA; const char* nB = has_next ? (const char*)g.Bt + (size_t)nxt.pn * g.tstepB : cB;
#pragma nounroll
        for (int t = 0; t < nt; t += 2) {
            const bool last = (t == nt - 2);
            const char* a1 = cA + (size_t)(t + 1) * kstepA;
            const char* a2 = last ? nA : cA + (size_t)(t + 2) * kstepA; const char* b2 = last ? nB : cB + (size_t)(t + 2) * kstep;
            const char* a3 = a2 + kstepA; const char* b3 = b2 + kstep;
            if constexpr (SP2) {
            PG8_LDB(B0, 0, 0); PG8_LDB(B1, 0, 1); PG8_SCHED; PG8_LDA(At, 0, 0); PG8_STAGE(PG8_SA(1, 1), a1 + hstepA, voffA);
            PG8_WAIT_V(8); PG8_WAIT_L(0); PG8_BAR; PG8_MMA(0, 0, At, B0); PG8_MMA(0, 1, At, B1); PG8_BAR; PG8_SCHED;
            PG8_LDA(At, 0, 1); PG8_STAGE(PG8_SB(0, 0), b2, voffB); PG8_STAGE(PG8_SB(0, 1), b2 + hstepB, voffB); PG8_STAGE(PG8_SA(0, 0), a2, voffA);
            PG8_WAIT_V(8); PG8_WAIT_L(0); PG8_BAR; PG8_MMA(1, 0, At, B0); PG8_MMA(1, 1, At, B1); PG8_BAR; PG8_SCHED;
            PG8_LDB(B0, 1, 0); PG8_LDB(B1, 1, 1); PG8_SCHED; PG8_LDA(At, 1, 0); PG8_STAGE(PG8_SA(0, 1), a2 + hstepA, voffA);
            PG8_WAIT_V(8); PG8_WAIT_L(0); PG8_BAR; PG8_MMA(0, 0, At, B0); PG8_MMA(0, 1, At, B1); PG8_BAR; PG8_SCHED;
            PG8_LDA(At, 1, 1); PG8_STAGE(PG8_SB(1, 0), b3, voffB); PG8_STAGE(PG8_SB(1, 1), b3 + hstepB, voffB); PG8_STAGE(PG8_SA(1, 0), a3, voffA);
            PG8_WAIT_V(8); PG8_WAIT_L(0); PG8_BAR; PG8_MMA(1, 0, At, B0); PG8_MMA(1, 1, At, B1); PG8_BAR; PG8_SCHED;
            } else {
            PG8_LDB(B0, 0, 0); PG8_SCHED; PG8_LDA(At, 0, 0); PG8_STAGE(PG8_SA(1, 1), a1 + hstepA, voffA);
            PG8_WAIT_L(8); PG8_BAR; PG8_WAIT_L(0); PG8_MMA(0, 0, At, B0); PG8_BAR; PG8_SCHED;
            PG8_LDB(B1, 0, 1); PG8_STAGE(PG8_SB(0, 0), b2, voffB);
            PG8_BAR; PG8_WAIT_L(0); PG8_MMA(0, 1, At, B1); PG8_BAR;
            PG8_LDA(At, 0, 1); PG8_STAGE(PG8_SA(0, 0), a2, voffA);
            PG8_BAR; PG8_WAIT_L(0); PG8_MMA(1, 0, At, B0); PG8_BAR; PG8_SCHED;
            PG8_STAGE(PG8_SB(0, 1), b2 + hstepB, voffB);
            PG8_WAIT_V(6); PG8_BAR; PG8_MMA(1, 1, At, B1); PG8_BAR;
            PG8_LDB(B0, 1, 0); PG8_SCHED; PG8_LDA(At, 1, 0); PG8_STAGE(PG8_SA(0, 1), a2 + hstepA, voffA);
            PG8_WAIT_L(8); PG8_BAR; PG8_WAIT_L(0); PG8_MMA(0, 0, At, B0); PG8_BAR; PG8_SCHED;
            PG8_LDB(B1, 1, 1); PG8_STAGE(PG8_SB(1, 0), b3, voffB);
            PG8_BAR; PG8_WAIT_L(0); PG8_MMA(0, 1, At, B1); PG8_BAR;
            PG8_LDA(At, 1, 1); PG8_STAGE(PG8_SA(1, 0), a3, voffA);
            PG8_BAR; PG8_WAIT_L(0); PG8_MMA(1, 0, At, B0); PG8_BAR; PG8_SCHED;
            PG8_STAGE(PG8_SB(1, 1), b3 + hstepB, voffB);
            PG8_WAIT_V(6); PG8_BAR; PG8_MMA(1, 1, At, B1); PG8_BAR;
            }
        }
        if constexpr (ALIGN_EPI) { if (wr == 0) PG8_BAR; }
        if constexpr (!Epi::AFTER_DRAIN) E(acc, cur, wr, wc, fr, fq);
        if (!has_next) break;
#pragma unroll
        for (int a = 0; a < 2; ++a)
#pragma unroll
            for (int b = 0; b < 2; ++b)
#pragma unroll
                for (int m = 0; m < 4; ++m)
#pragma unroll
                    for (int n = 0; n < 2; ++n) acc[a][b][m][n] = (f32x4){0.f, 0.f, 0.f, 0.f};
        cur = nxt; cA = nA; cB = nB; ++ui;
        if constexpr (ALIGN_EPI) { if (wr == 1) PG8_BAR; }
    }
    PG8_WAIT_V(0);
    if constexpr (!ALIGN_EPI) { if (wr == 0) PG8_BAR; }
    PG8_BAR;
    if constexpr (Epi::AFTER_DRAIN) E.fused(acc, cur, wr, wc, fr, fq, lds, wid, lane);
#undef PG8_SA
#undef PG8_SB
#undef PG8_STAGE
#undef PG8_LDA
#undef PG8_LDB
#undef PG8_MMA
#undef PG8_WAIT_V
#undef PG8_WAIT_L
#undef PG8_BAR
#undef PG8_SCHED
}

__device__ __forceinline__ u32x4 pack8(f32x4 a, f32x4 b) { u32x4 w; w.x = cvt_pk_bf16(a[0], a[1]); w.y = cvt_pk_bf16(a[2], a[3]); w.z = cvt_pk_bf16(b[0], b[1]); w.w = cvt_pk_bf16(b[2], b[3]); return w; }

template <int ACT  > struct EpiBf16 {
    static constexpr bool PERM = true, AFTER_DRAIN = false;
    bf16_t* O; int ldc; int gs;
    const float* ssq; float inv_n;
    int pn_mask = -1;
    __device__ __forceinline__ void operator()(const Acc& acc, const Unit& u, int wr, int wc, int fr, int fq) const {
        const int row0 = u.pm * BM + wr * 64 + fr, col0 = (u.pn & pn_mask) * 2 * gs + wc * 32 + 8 * fq;
#pragma unroll
        for (int ai = 0; ai < 2; ++ai)
#pragma unroll
            for (int m = 0; m < 4; ++m) { bf16_t* rowp = O + (size_t)(row0 + ai * HALF + m * 16) * ldc + col0;
                const float rs = ssq ? 1.0f / sqrtf(ssq[row0 + ai * HALF + m * 16] * inv_n + 1e-6f) : 1.0f;
#pragma unroll
                for (int bj = 0; bj < 2; ++bj) { f32x4 v0 = acc[ai][bj][m][0] * rs, v1 = acc[ai][bj][m][1] * rs;
                    if (ACT == 1) { v0 = __builtin_elementwise_max(v0, (f32x4){0.f, 0.f, 0.f, 0.f}); v1 = __builtin_elementwise_max(v1, (f32x4){0.f, 0.f, 0.f, 0.f}); v0 = v0 * v0; v1 = v1 * v1; }
                    if (ACT == 2) {
#pragma unroll
                        for (int j = 0; j < 4; ++j) { const float a = v0[j], za = 1.5957691216f * (a + 0.044715f * a * a * a); v0[j] = a * __builtin_amdgcn_rcpf(1.0f + __expf(-za));
                            const float b = v1[j], zb = 1.5957691216f * (b + 0.044715f * b * b * b); v1[j] = b * __builtin_amdgcn_rcpf(1.0f + __expf(-zb)); } }
                    *(u32x4*)(rowp + bj * gs) = pack8(v0, v1); } }
    }
};
struct EpiGlu {
    static constexpr bool PERM = true, AFTER_DRAIN = false;
    bf16_t* O; int ldc;
    __device__ __forceinline__ void operator()(const Acc& acc, const Unit& u, int wr, int wc, int fr, int fq) const {
        const int row0 = u.pm * BM + wr * 64 + fr, col0 = u.pn * HALF + wc * 32 + 8 * fq;
#pragma unroll
        for (int ai = 0; ai < 2; ++ai)
#pragma unroll
            for (int m = 0; m < 4; ++m) { bf16_t* rowp = O + (size_t)(row0 + ai * HALF + m * 16) * ldc + col0;
                f32x4 o[2];
#pragma unroll
                for (int n = 0; n < 2; ++n) { const f32x4 v = acc[ai][0][m][n], gt = acc[ai][1][m][n];
#pragma unroll
                    for (int j = 0; j < 4; ++j) o[n][j] = v[j] * __builtin_amdgcn_rcpf(1.0f + __expf(-gt[j])); }
                *(u32x4*)rowp = pack8(o[0], o[1]); }
    }
};
struct EpiRes {
    static constexpr bool PERM = false, AFTER_DRAIN = false;
    const float* base; float* R; int ldc; float alpha;
    __device__ __forceinline__ void operator()(const Acc& acc, const Unit& u, int wr, int wc, int fr, int fq) const {
        const int row0 = u.pm * BM + wr * 64 + fr, col0 = u.pn * BM + wc * 32 + 4 * fq;
#pragma unroll
        for (int ai = 0; ai < 2; ++ai)
#pragma unroll
            for (int m = 0; m < 4; ++m) { const size_t off = (size_t)(row0 + ai * HALF + m * 16) * ldc + col0;
                f32x4 bs[2][2];
#pragma unroll
                for (int bj = 0; bj < 2; ++bj)
#pragma unroll
                    for (int n = 0; n < 2; ++n) bs[bj][n] = *(const f32x4*)(base + off + bj * HALF + n * 16);
#pragma unroll
                for (int bj = 0; bj < 2; ++bj)
#pragma unroll
                    for (int n = 0; n < 2; ++n) *(f32x4*)(R + off + bj * HALF + n * 16) = bs[bj][n] * alpha + acc[ai][bj][m][n];
                asm volatile("" ::: "memory"); }
    }
};

struct PanelStats {
    unsigned* xbuf;
    unsigned* cnt;
    float eps;
    __device__ __forceinline__ void run(const Acc& v, const Unit& u, int wr, int wc, int fr, int fq, PG8_LAS unsigned char* lds, int wid, int lane) const {
        PG8_LAS f32x2* P = (PG8_LAS f32x2*)lds;
        PG8_LAS f32x2* S = (PG8_LAS f32x2*)(lds + 8192);
#pragma unroll
        for (int ai = 0; ai < 2; ++ai)
#pragma unroll
            for (int m = 0; m < 4; ++m) {
                float s = 0.f;
#pragma unroll
                for (int bj = 0; bj < 2; ++bj)
#pragma unroll
                    for (int n = 0; n < 2; ++n) { const f32x4 x = v[ai][bj][m][n]; s += (x[0] + x[1]) + (x[2] + x[3]); }
                s += __shfl_xor(s, 16); s += __shfl_xor(s, 32);
                const float mw = s * (1.0f / 64.0f); float q = 0.f;
#pragma unroll
                for (int bj = 0; bj < 2; ++bj)
#pragma unroll
                    for (int n = 0; n < 2; ++n) { const f32x4 d = v[ai][bj][m][n] - mw; q += (d[0] * d[0] + d[1] * d[1]) + (d[2] * d[2] + d[3] * d[3]); }
                q += __shfl_xor(q, 16); q += __shfl_xor(q, 32);
                if (fq == 0) P[(ai * HALF + wr * 64 + m * 16 + fr) * 4 + wc] = (f32x2){mw, q};
            }
        asm volatile("s_waitcnt lgkmcnt(0)" ::: "memory"); __builtin_amdgcn_s_barrier(); asm volatile("" ::: "memory");
        const int row = wid * 32 + (lane & 31);
        if (lane < 32) {
            const f32x2 a = P[row * 4 + 0], b = P[row * 4 + 1], c = P[row * 4 + 2], d = P[row * 4 + 3];
            const float mt = (a.x + b.x + c.x + d.x) * 0.25f;
            const float da = a.x - mt, db = b.x - mt, dc = c.x - mt, dd = d.x - mt;
            const float m2 = (a.y + b.y) + (c.y + d.y) + 64.0f * ((da * da + db * db) + (dc * dc + dd * dd));
            unsigned long long* slot = (unsigned long long*)xbuf + ((size_t)(u.pm * BM + row) * 4 + u.pn);
            __hip_atomic_store(slot, ((unsigned long long)__float_as_uint(m2) << 32) | __float_as_uint(mt), __ATOMIC_RELAXED, __HIP_MEMORY_SCOPE_AGENT);
        }
        asm volatile("s_waitcnt vmcnt(0)" ::: "memory");
        if (lane == 0) __hip_atomic_fetch_add(cnt + 64 * u.pm, 1u, __ATOMIC_RELAXED, __HIP_MEMORY_SCOPE_AGENT);
        if (wid == 0) {
            for (unsigned spin = 0; spin < (1u << 22); ++spin) {
                if ((unsigned)__builtin_amdgcn_readfirstlane(__hip_atomic_load(cnt + 64 * u.pm, __ATOMIC_RELAXED, __HIP_MEMORY_SCOPE_AGENT)) >= 32u) break;
                __builtin_amdgcn_s_sleep(2);
            }
            __builtin_amdgcn_fence(__ATOMIC_ACQUIRE, "agent");
        }
        asm volatile("s_waitcnt vmcnt(0) lgkmcnt(0)" ::: "memory"); __builtin_amdgcn_s_barrier(); asm volatile("" ::: "memory");
        if (lane < 32) {
            const unsigned long long* slot = (const unsigned long long*)xbuf + (size_t)(u.pm * BM + row) * 4; float mt[4], m2[4]; float ms = 0.f;
#pragma unroll
            for (int t = 0; t < 4; ++t) { const unsigned long long w = __hip_atomic_load(slot + t, __ATOMIC_RELAXED, __HIP_MEMORY_SCOPE_AGENT); mt[t] = __uint_as_float((unsigned)w); m2[t] = __uint_as_float((unsigned)(w >> 32)); ms += mt[t]; }
            const float mean = ms * 0.25f; float q = 0.f;
#pragma unroll
            for (int t = 0; t < 4; ++t) { const float dm = mt[t] - mean; q += m2[t] + 256.0f * dm * dm; }
            S[row] = (f32x2){mean, 1.0f / sqrtf(q * (1.0f / 1024.0f) + eps)};
        }
        asm volatile("s_waitcnt lgkmcnt(0)" ::: "memory"); __builtin_amdgcn_s_barrier(); asm volatile("" ::: "memory");
    }
};
template <int BASE_BF16  , bool OUT_F32> struct EpiResLn {
    static constexpr bool PERM = false, AFTER_DRAIN = false;
    const void* base; void* out; const float* gam; const float* bet; float alpha; PanelStats st; PG8_LAS unsigned char* tab;
    __device__ __forceinline__ void operator()(Acc& acc, const Unit& u, int wr, int wc, int fr, int fq) const { fused(acc, u, wr, wc, fr, fq, tab, wr * 4 + wc, lane_id()); }
    __device__ __forceinline__ void fused(Acc& acc, const Unit& u, int wr, int wc, int fr, int fq, PG8_LAS unsigned char* lds, int wid, int lane) const {
        const PG8_LAS f32x2* S = (const PG8_LAS f32x2*)(lds + 8192);
        const int col0 = u.pn * BM + wc * 32 + 4 * fq;
#pragma unroll
        for (int ai = 0; ai < 2; ++ai)
#pragma unroll
            for (int m = 0; m < 4; ++m) { const size_t off = (size_t)(u.pm * BM + ai * HALF + wr * 64 + m * 16 + fr) * 1024 + col0;
                f32x4 bs[2][2];
#pragma unroll
                for (int bj = 0; bj < 2; ++bj)
#pragma unroll
                    for (int n = 0; n < 2; ++n) {
                        if constexpr (BASE_BF16 != 0) { const int tok_ = u.pm * BM + ai * HALF + wr * 64 + m * 16 + fr, col_ = col0 + bj * HALF + n * 16;
                            const size_t boff = (BASE_BF16 == 2) ? ((size_t)(col_ >> 4) * 1024 + (tok_ >> 5)) * 640 + (tok_ & 31) * 16 + (col_ & 15) : off + bj * HALF + n * 16;
                            const f32x2 w = *(const f32x2*)((const bf16_t*)base + boff); const unsigned w0 = __float_as_uint(w.x), w1 = __float_as_uint(w.y);
                            bs[bj][n] = (f32x4){__uint_as_float(w0 << 16), __uint_as_float(w0 & 0xffff0000u), __uint_as_float(w1 << 16), __uint_as_float(w1 & 0xffff0000u)}; }
                        else bs[bj][n] = *(const f32x4*)((const float*)base + off + bj * HALF + n * 16); }
#pragma unroll
                for (int bj = 0; bj < 2; ++bj)
#pragma unroll
                    for (int n = 0; n < 2; ++n) acc[ai][bj][m][n] += bs[bj][n] * alpha;
                asm volatile("" : "+v"(acc[ai][0][m][0]), "+v"(acc[ai][0][m][1]), "+v"(acc[ai][1][m][0]), "+v"(acc[ai][1][m][1]));
                asm volatile("" ::: "memory"); }
        st.run(acc, u, wr, wc, fr, fq, lds, wid, lane);
#pragma unroll
        for (int bj = 0; bj < 2; ++bj)
#pragma unroll
            for (int n = 0; n < 2; ++n) { const int cc = col0 + bj * HALF + n * 16;
                const f32x4 gg = *(const f32x4*)(gam + cc), bb = *(const f32x4*)(bet + cc);
#pragma unroll
                for (int ai = 0; ai < 2; ++ai)
#pragma unroll
                    for (int m = 0; m < 4; ++m) { const int r = ai * HALF + wr * 64 + m * 16 + fr; const f32x2 sr = S[r]; const size_t off = (size_t)(u.pm * BM + r) * 1024 + cc;
                        const f32x4 y = (acc[ai][bj][m][n] - sr.x) * sr.y * gg + bb;
                        if constexpr (OUT_F32) *(f32x4*)((float*)out + off) = y;
                        else { f32x2 w; const unsigned w0 = cvt_pk_bf16(y[0], y[1]), w1 = cvt_pk_bf16(y[2], y[3]); w.x = __uint_as_float(w0); w.y = __uint_as_float(w1); *(f32x2*)((bf16_t*)out + off) = w; } }
                asm volatile("" ::: "memory"); }
        __builtin_amdgcn_s_barrier();
    }
};
struct EpiQKVA {
    static constexpr bool PERM = true, AFTER_DRAIN = false;
    bf16_t* CKV; bf16_t* CQ; bf16_t* KR; const float* CS; float* ssq_kv; float* ssq_q;
    __device__ __forceinline__ void operator()(const Acc& acc, const Unit& u, int wr, int wc, int fr, int fq) const {
        const int row0 = u.pm * BM + wr * 64 + fr;
        if (u.pn == 3) {
            if (wc != 0) return;
            const int i0 = 8 * fq;
#pragma unroll
            for (int ai = 0; ai < 2; ++ai)
#pragma unroll
                for (int m = 0; m < 4; ++m) { const int row = row0 + ai * HALF + m * 16;
                    f32x4 o1[2], o2[2];
#pragma unroll
                    for (int n = 0; n < 2; ++n) { const f32x4 cs = *(const f32x4*)(CS + (size_t)row * 64 + i0 + 4 * n), sn = *(const f32x4*)(CS + (size_t)row * 64 + 32 + i0 + 4 * n);
                        const f32x4 x1 = acc[ai][0][m][n], x2 = acc[ai][1][m][n];
                        o1[n] = x1 * cs - x2 * sn; o2[n] = x1 * sn + x2 * cs; }
                    bf16_t* kp = KR + (size_t)row * 64 + i0;
                    *(u32x4*)kp = pack8(o1[0], o1[1]); *(u32x4*)(kp + 32) = pack8(o2[0], o2[1]); }
            return;
        }
        const int nbj = (u.pn == 2) ? 1 : 2;
        bf16_t* O = (u.pn == 0) ? CKV : CQ + (u.pn - 1) * 256; const int ldc = (u.pn == 0) ? 256 : 384; float* ssq = (u.pn == 0) ? ssq_kv : ssq_q;
        const int col0 = wc * 32 + 8 * fq;
#pragma unroll
        for (int ai = 0; ai < 2; ++ai)
#pragma unroll
            for (int m = 0; m < 4; ++m) { const int row = row0 + ai * HALF + m * 16; float s = 0.f;
#pragma unroll
                for (int bj = 0; bj < 2; ++bj) if (bj < nbj) { const f32x4 v0 = acc[ai][bj][m][0], v1 = acc[ai][bj][m][1];
                    s += (v0[0] * v0[0] + v0[1] * v0[1]) + (v0[2] * v0[2] + v0[3] * v0[3]) + (v1[0] * v1[0] + v1[1] * v1[1]) + (v1[2] * v1[2] + v1[3] * v1[3]);
                    *(u32x4*)(O + (size_t)row * ldc + col0 + bj * HALF) = pack8(v0, v1); }
                s += __shfl_xor(s, 16); s += __shfl_xor(s, 32);
                if (fq == 0) atomicAdd(ssq + row, s); }
    }
};
struct EpiS1 {
    static constexpr bool PERM = false, AFTER_DRAIN = false;
    float* E;
    __device__ __forceinline__ void operator()(const Acc& acc, const Unit& u, int wr, int wc, int fr, int fq) const {
        const int row0 = u.pm * BM + wr * 64 + fr, col0 = wc * 32 + 4 * fq;
#pragma unroll
        for (int ai = 0; ai < 2; ++ai)
#pragma unroll
            for (int m = 0; m < 4; ++m) { const size_t off = (size_t)(row0 + ai * HALF + m * 16) * 128 + col0;
#pragma unroll
                for (int n = 0; n < 2; ++n) *(f32x4*)(E + off + n * 16) = acc[ai][0][m][n]; }
    }
};
struct EpiS3 {
    static constexpr bool PERM = true, AFTER_DRAIN = false;
    bf16_t* Y;
    __device__ __forceinline__ void operator()(const Acc& acc, const Unit& u, int wr, int wc, int fr, int fq) const {
        const int g = u.pm >> 2, rloc = (u.pm & 3) * BM + wr * 64 + fr;
        const int co0 = 8 * (fq & 1);
#pragma unroll
        for (int ai = 0; ai < 2; ++ai)
#pragma unroll
            for (int m = 0; m < 4; ++m) { const int r = rloc + ai * HALF + m * 16;
#pragma unroll
                for (int bj = 0; bj < 2; ++bj) { const int t = 16 * (u.pn & 1) + 8 * bj + 2 * wc + (fq >> 1);
                    f32x4 o[2];
#pragma unroll
                    for (int n = 0; n < 2; ++n)
#pragma unroll
                        for (int j = 0; j < 4; ++j) { const float v = acc[ai][bj][m][n][j]; const float z = 1.5957691216f * (v + 0.044715f * v * v * v);
                            o[n][j] = v * __builtin_amdgcn_rcpf(1.0f + __expf(-z)); }
                    *(u32x4*)(Y + ((size_t)r * 32 + t) * 1024 + g * 16 + co0) = pack8(o[0], o[1]); } }
    }
};
struct EpiQ {
    static constexpr bool PERM = true, AFTER_DRAIN = false;
    bf16_t* Q; const float* CS; const float* ssq;
    __device__ __forceinline__ void operator()(const Acc& acc, const Unit& u, int wr, int wc, int fr, int fq) const {
        const int row0 = u.pm * BM + wr * 64 + fr;
        if (u.pn < 4) {
            const int col0 = u.pn * 384 + wc * 32 + 8 * fq;
#pragma unroll
            for (int ai = 0; ai < 2; ++ai)
#pragma unroll
                for (int m = 0; m < 4; ++m) { const int row = row0 + ai * HALF + m * 16; const float rs = 1.0f / sqrtf(ssq[row] * (1.0f / 384.0f) + 1e-6f);
                    bf16_t* rowp = Q + (size_t)row * 1536 + col0;
#pragma unroll
                    for (int bj = 0; bj < 2; ++bj) *(u32x4*)(rowp + bj * 192) = pack8(acc[ai][bj][m][0] * rs, acc[ai][bj][m][1] * rs);
                    asm volatile("" ::: "memory"); }
            return;
        }
        const int h = (u.pn - 4) * 4 + wc, i0 = 8 * fq;
#pragma unroll
        for (int ai = 0; ai < 2; ++ai)
#pragma unroll
            for (int m = 0; m < 4; ++m) { const int row = row0 + ai * HALF + m * 16;
                f32x4 o1[2], o2[2]; const float rs = 1.0f / sqrtf(ssq[row] * (1.0f / 384.0f) + 1e-6f);
#pragma unroll
                for (int n = 0; n < 2; ++n) { const f32x4 cs = *(const f32x4*)(CS + (size_t)row * 64 + i0 + 4 * n), sn = *(const f32x4*)(CS + (size_t)row * 64 + 32 + i0 + 4 * n);
                    const f32x4 x1 = acc[ai][0][m][n] * rs, x2 = acc[ai][1][m][n] * rs;
                    o1[n] = x1 * cs - x2 * sn; o2[n] = x1 * sn + x2 * cs; }
                bf16_t* qp = Q + (size_t)row * 1536 + h * 192 + 128 + i0;
                *(u32x4*)qp = pack8(o1[0], o1[1]); *(u32x4*)(qp + 32) = pack8(o2[0], o2[1]);
                asm volatile("" ::: "memory"); }
    }
};

struct EpiS1Scan {
    static constexpr bool PERM = false, AFTER_DRAIN = true;
    bf16_t* Xg; const float* AL;
    __device__ __forceinline__ void fused(Acc& acc, const Unit& u, int wr, int wc, int fr, int fq, PG8_LAS unsigned char* lds, int wid, int lane) const {
        constexpr int ES = 132;
        PG8_LAS float* E = (PG8_LAS float*)lds;
#pragma unroll
        for (int ai = 0; ai < 2; ++ai)
#pragma unroll
            for (int m = 0; m < 4; ++m) { const int row = ai * HALF + wr * 64 + m * 16 + fr;
#pragma unroll
                for (int n = 0; n < 2; ++n) *(PG8_LAS f32x4*)(E + row * ES + wc * 32 + n * 16 + 4 * fq) = acc[ai][0][m][n]; }
        asm volatile("s_waitcnt lgkmcnt(0)" ::: "memory"); __builtin_amdgcn_s_barrier(); asm volatile("" ::: "memory");
        if (wid < 2) {
            const int g = u.pm >> 2, b = 2 * (u.pm & 3) + wid, p = lane;
            const float ar = AL[(g * 64 + p) * 2], ai_ = AL[(g * 64 + p) * 2 + 1];
            float hr = 0.f, hi = 0.f;
            const PG8_LAS float* Ep = E + (wid * 128) * ES + p;
            bf16_t* Hp = Xg + ((size_t)g * 1024 + b * 128) * 640 + 512 + p;
            for (int c0 = 0; c0 < 128; c0 += 16) {
                float er[16], ei[16];
#pragma unroll
                for (int k = 0; k < 16; ++k) { er[k] = Ep[(c0 + k) * ES]; ei[k] = Ep[(c0 + k) * ES + 64]; }
#pragma unroll
                for (int k = 0; k < 16; ++k) { const unsigned ph = cvt_pk_bf16(hr, hi); Hp[(size_t)(c0 + k) * 640] = (bf16_t)(ph & 0xffffu); Hp[(size_t)(c0 + k) * 640 + 64] = (bf16_t)(ph >> 16);
                    const float nr = ar * hr - ai_ * hi + er[k], ni = ar * hi + ai_ * hr + ei[k]; hr = nr; hi = ni; }
            }
        }
        asm volatile("s_waitcnt vmcnt(0) lgkmcnt(0)" ::: "memory"); __builtin_amdgcn_s_barrier(); asm volatile("" ::: "memory");
    }
};
struct PairOrder {
    int pmg;
    __device__ bool next(int i, Unit& u) const { if (i >= 2) return false; u.pm = pmg; u.pn = (pmg >> 2) * 2 + i; return true; }
};
}

namespace att {
using bf16 = __hip_bfloat16;
typedef short bf16x8 __attribute__((ext_vector_type(8)));
typedef short s16x4 __attribute__((ext_vector_type(4)));
typedef float f32x16 __attribute__((ext_vector_type(16)));
typedef float f32x4 __attribute__((ext_vector_type(4)));
typedef unsigned u32x4 __attribute__((ext_vector_type(4)));
constexpr int NW = 8, QBLK = 32, KVBLK = 64, QB = NW * QBLK, DV = 128, DK = 192;
constexpr int SEQ = 4096, NQB = SEQ / QB;
constexpr int QS = 1536, KVS = 2048, KRS = 64, OS = 1024;
constexpr int SHM_V = KVBLK * DV * 2, SHM_K = KVBLK * DK * 2;
constexpr int NQR = 6, NQLDS = 12 - NQR, QSLOT = NQLDS * 1024;
constexpr int NVB = 3;
constexpr int WS_OFF = NVB * SHM_V + 2 * SHM_K, QR_OFF = WS_OFF + NW * 64 * 4, LDS_BYTES = QR_OFF + NW * QSLOT;
constexpr float SCALE = 0.07216878364870322f;
constexpr float THR = 8.f;
#define KSWZ(row, colB) ((row) * 384 + ((colB) ^ (((row) & 7) << 4)))
#define SBAR() __builtin_amdgcn_sched_barrier(0)
__device__ __forceinline__ int v_st(int k, int c) { const int kk = (k & ~0xC) | ((k & 4) << 1) | ((k & 8) >> 1); return ((kk >> 3) * 4 + (c >> 5)) * 512 + ((kk & 7) * 32 + (c & 31)) * 2; }
__device__ __forceinline__ int v_rd_base(int lane) { return ((lane & 3) << 3) | (((lane >> 2) & 3) << 6) | (((lane >> 4) & 1) << 5) | (((lane >> 5) & 1) << 8); }
constexpr int v_rd_off(int d0, int ks, int half) { return d0 * 512 + ks * 4096 + half * 2048; }
__device__ __forceinline__ int crow(int r, int hi) { return (r & 3) + 8 * (r >> 2) + 4 * hi; }
__device__ __forceinline__ unsigned cvtpk(float lo, float hi) { unsigned r; asm volatile("v_cvt_pk_bf16_f32 %0, %1, %2" : "=v"(r) : "v"(lo), "v"(hi)); return r; }
__device__ __forceinline__ bf16x8 load8(const bf16* p) { return *reinterpret_cast<const bf16x8*>(p); }
__device__ __forceinline__ void mask_tile(f32x16& p0, f32x16& p1, int dq, unsigned W) {
    const float NEG = -__builtin_inff();
#pragma unroll
    for (int r = 0; r < 16; ++r) {
        const int c = (r & 3) + 8 * (r >> 2);
        if ((unsigned)(dq - c) >= W) p0[r] = NEG;
        if ((unsigned)(dq - c - 32) >= W) p1[r] = NEG;
    }
}
__device__ __forceinline__ void partialSM(f32x16& p0, f32x16& p1, float& m_reg, float& mn, float& alpha) {
    float pmax = p0[0]; for (int r = 1; r < 16; ++r) pmax = fmaxf(pmax, p0[r]); for (int r = 0; r < 16; ++r) pmax = fmaxf(pmax, p1[r]);
    { auto rr = __builtin_amdgcn_permlane32_swap(__float_as_uint(pmax), __float_as_uint(pmax), false, false);
      pmax = fmaxf(__uint_as_float(rr[0]), __uint_as_float(rr[1])); }
    constexpr float C2 = 1.4426950408889634f * SCALE;
    if (__builtin_expect(__all((pmax - m_reg) * SCALE <= THR), 1)) { mn = m_reg; alpha = 1.f; }
    else { mn = fmaxf(m_reg, pmax); alpha = __builtin_amdgcn_exp2f((m_reg - mn) * C2); m_reg = mn; }
    const float mnL = -mn * C2;
    for (int r = 0; r < 16; ++r) p0[r] = fmaf(p0[r], C2, mnL); for (int r = 0; r < 16; ++r) p1[r] = fmaf(p1[r], C2, mnL);
    for (int r = 0; r < 16; ++r) p0[r] = __builtin_amdgcn_exp2f(p0[r]);
}
__device__ __forceinline__ void finishSM(f32x16& p0, f32x16& p1, float alpha, float& l_reg, bf16x8& pa0, bf16x8& pa1, bf16x8& pa2, bf16x8& pa3) {
    for (int r = 0; r < 16; ++r) p1[r] = __builtin_amdgcn_exp2f(p1[r]);
    float ps = 0; for (int r = 0; r < 16; ++r) ps += p0[r]; for (int r = 0; r < 16; ++r) ps += p1[r];
    { auto rr = __builtin_amdgcn_permlane32_swap(__float_as_uint(ps), __float_as_uint(ps), false, false);
      ps = __uint_as_float(rr[0]) + __uint_as_float(rr[1]); }
    l_reg = l_reg * alpha + ps;
#define PK4(P, B_, OUT) do { unsigned a0 = cvtpk(P[B_+0], P[B_+1]), a1 = cvtpk(P[B_+2], P[B_+3]);                          \
        unsigned b0 = cvtpk(P[B_+4], P[B_+5]), b1 = cvtpk(P[B_+6], P[B_+7]);                                             \
        auto r0 = __builtin_amdgcn_permlane32_swap(a0, b0, false, false); auto r1 = __builtin_amdgcn_permlane32_swap(a1, b1, false, false); \
        u32x4 w = {r0[0], r1[0], r0[1], r1[1]}; OUT = *reinterpret_cast<bf16x8*>(&w); } while (0)
    PK4(p0, 0, pa0); PK4(p0, 8, pa1); PK4(p1, 0, pa2); PK4(p1, 8, pa3);
#undef PK4
}
template <int KB>
__device__ __forceinline__ void qkt(f32x16& p0, f32x16& p1, const char* K_lds, int r32, int hi, const bf16x8* qr, const char* qrope) {
    p0 = f32x16{}; p1 = f32x16{};
    __builtin_amdgcn_s_setprio(1);
    const char* kb[4];
#pragma unroll
    for (int dd = 0; dd < 4; ++dd) kb[dd] = K_lds + KB * SHM_K + KSWZ(r32, (dd * 16 + hi * 8) * 2);
#pragma unroll
    for (int d0 = 0; d0 < NQR; ++d0) { const char* a = kb[d0 & 3] + (d0 >> 2) * 128;
        bf16x8 b0 = *reinterpret_cast<const bf16x8*>(a);
        bf16x8 b1 = *reinterpret_cast<const bf16x8*>(a + 32 * 384);
        p0 = __builtin_amdgcn_mfma_f32_32x32x16_bf16(b0, qr[d0], p0, 0, 0, 0);
        p1 = __builtin_amdgcn_mfma_f32_32x32x16_bf16(b1, qr[d0], p1, 0, 0, 0);
        if ((d0 & 3) == 3) SBAR(); }
#pragma unroll
    for (int d0 = NQR; d0 < 12; ++d0) { const char* a = kb[d0 & 3] + (d0 >> 2) * 128;
        bf16x8 b0 = *reinterpret_cast<const bf16x8*>(a);
        bf16x8 b1 = *reinterpret_cast<const bf16x8*>(a + 32 * 384);
        bf16x8 q = *reinterpret_cast<const bf16x8*>(qrope + (d0 - NQR) * 1024);
        p0 = __builtin_amdgcn_mfma_f32_32x32x16_bf16(b0, q, p0, 0, 0, 0);
        p1 = __builtin_amdgcn_mfma_f32_32x32x16_bf16(b1, q, p1, 0, 0, 0);
        if ((d0 & 3) == 3 && d0 != 11) SBAR(); }
    __builtin_amdgcn_s_setprio(0);
}
template <int VB>
__device__ __forceinline__ void pv_tile(f32x16* o, int vb0, bf16x8 pa0, bf16x8 pa1, bf16x8 pa2, bf16x8 pa3) {
#define TRRD(dst, off) asm volatile("ds_read_b64_tr_b16 %0, %1 offset:%2" : "=&v"(dst) : "v"(vb0), "i"(off) : "memory")
#define PV_D0(d0) do { s16x4 l0, l1, l2, l3, h0, h1, h2, h3; constexpr int b_ = VB * SHM_V + v_rd_off(d0, 0, 0); \
        TRRD(l0, b_); TRRD(h0, b_ + 2048); TRRD(l1, b_ + 4096); TRRD(h1, b_ + 6144); TRRD(l2, b_ + 8192); TRRD(h2, b_ + 10240); TRRD(l3, b_ + 12288); TRRD(h3, b_ + 14336); \
        asm volatile("s_waitcnt lgkmcnt(0)" ::: "memory"); SBAR();   \
        o[d0] = __builtin_amdgcn_mfma_f32_32x32x16_bf16(pa0, (bf16x8){l0[0], l0[1], l0[2], l0[3], h0[0], h0[1], h0[2], h0[3]}, o[d0], 0, 0, 0);   \
        o[d0] = __builtin_amdgcn_mfma_f32_32x32x16_bf16(pa1, (bf16x8){l1[0], l1[1], l1[2], l1[3], h1[0], h1[1], h1[2], h1[3]}, o[d0], 0, 0, 0);   \
        o[d0] = __builtin_amdgcn_mfma_f32_32x32x16_bf16(pa2, (bf16x8){l2[0], l2[1], l2[2], l2[3], h2[0], h2[1], h2[2], h2[3]}, o[d0], 0, 0, 0);   \
        o[d0] = __builtin_amdgcn_mfma_f32_32x32x16_bf16(pa3, (bf16x8){l3[0], l3[1], l3[2], l3[3], h3[0], h3[1], h3[2], h3[3]}, o[d0], 0, 0, 0); } while (0)
    __builtin_amdgcn_s_setprio(1); PV_D0(0); PV_D0(1); PV_D0(2); PV_D0(3); __builtin_amdgcn_s_setprio(0);
#undef PV_D0
#undef TRRD
}
struct BlockRef { const bf16* Q; const bf16* K; const bf16* V; const bf16* KR; bf16* O; int P0; };
struct Tensors { const bf16* Q; const bf16* KV; const bf16* KR; bf16* O; };
__device__ __forceinline__ BlockRef mk_ref(const Tensors& T, int bh, int qb) {
    const int b = bh >> 3, h = bh & 7; BlockRef r;
    r.Q = T.Q + ((size_t)b * SEQ + (size_t)qb * QB) * QS + h * DK;
    r.K = T.KV + (size_t)b * SEQ * KVS + h * 256; r.V = r.K + 128;
    r.KR = T.KR + (size_t)b * SEQ * KRS;
    r.O = T.O + ((size_t)b * SEQ + (size_t)qb * QB) * OS + h * DV; r.P0 = qb * QB;
    return r;
}
struct Seam { bf16x8 qr[NQR]; bf16x8 st_v0, st_v1, st_k0, st_k1, st_k2; };
#define ROWK(p, k0, rr) (((p) + (size_t)(k0) * KVS) + (unsigned)((rr) * KVS + sc))
#define VMW() asm volatile("s_waitcnt vmcnt(0)" ::: "memory")
#define LBAR() asm volatile("s_waitcnt lgkmcnt(0)\n\ts_barrier" ::: "memory")
#define VMWN(n) asm volatile("s_waitcnt vmcnt(%0)" :: "i"(n) : "memory")
#define SLOAD_H(Kp, Vp, KRp, k0) do { S.st_v0 = load8(ROWK(Vp, k0, sr)); S.st_v1 = load8(ROWK(Vp, k0, 32 + sr));              \
                         S.st_k0 = load8(ROWK(Kp, k0, sr)); S.st_k1 = load8(ROWK(Kp, k0, 32 + sr)); S.st_k2 = load8(((KRp) + (size_t)(k0) * KRS) + (unsigned)(rr8 * KRS + rc8)); } while (0)
#define SWRITE_HK(bf) do { *(bf16x8*)(K_lds + (bf) * SHM_K + kws) = S.st_k0; *(bf16x8*)(K_lds + (bf) * SHM_K + kws + 32 * 384) = S.st_k1; *(bf16x8*)(K_lds + (bf) * SHM_K + kws2) = S.st_k2; } while (0)
#define SWRITE_HV(bf) do { *(bf16x8*)(V_lds + (bf) * SHM_V + vst0) = S.st_v0; *(bf16x8*)(V_lds + (bf) * SHM_V + vst1) = S.st_v1; } while (0)
#define SWRITE_H(bf) do { SWRITE_HV(bf); SWRITE_HK(bf); } while (0)
__device__ __forceinline__ void attn_prime(const BlockRef& cur, char* lds, Seam& S, int wave_id) {
    int tid_ = (wave_id << 6) | lane_id(); asm volatile("" : "+v"(tid_));
    const int tid = tid_, wid = __builtin_amdgcn_readfirstlane(tid >> 6), lane = tid & 63, r32 = lane & 31, hi = lane >> 5;
    const int sr = tid >> 4, sc = (tid & 15) * 8, kws = KSWZ(sr, sc * 2), rr8 = tid >> 3, rc8 = (tid & 7) * 8, kws2 = KSWZ(rr8, (128 + rc8) * 2); char* K_lds = lds + NVB * SHM_V;
    char* qrope = lds + QR_OFF + wid * QSLOT + lane * 16;
    const bf16* qrow = cur.Q + (size_t)(wid * QBLK + r32) * QS + hi * 8;
#pragma unroll
    for (int d0 = 0; d0 < NQR; ++d0) S.qr[d0] = load8(qrow + d0 * 16);
#pragma unroll
    for (int d0 = NQR; d0 < 12; ++d0) *(bf16x8*)(qrope + (d0 - NQR) * 1024) = load8(qrow + d0 * 16);
    SLOAD_H(cur.K, cur.V, cur.KR, 0); VMW(); SWRITE_HK(0);
    __syncthreads();
}
__device__ __forceinline__ void attn_block(const Tensors& T, int bh, int qb, int bhn, int qbn, char* lds, Seam& S, int wave_id) {
    const BlockRef cur = mk_ref(T, bh, qb);
    int tid_ = (wave_id << 6) | lane_id(); asm volatile("" : "+v"(tid_));
    const int tid = tid_, wid = __builtin_amdgcn_readfirstlane(tid >> 6), lane = tid & 63, r32 = lane & 31, hi = lane >> 5;
    constexpr int W = SEQ;
    const int NT = (cur.P0 + QB - 1) / KVBLK + 1;
    const int qlo = cur.P0 + wid * QBLK, qm = qlo + r32 - 4 * hi;
    char* V_lds = lds; char* K_lds = lds + NVB * SHM_V;
    float* ws = (float*)(lds + WS_OFF) + wid * 64; float* li_l = ws, * al_l = ws + 32;
    char* qrope = lds + QR_OFF + wid * QSLOT + lane * 16;
    float m_reg = -1e30f, l_reg = 0; f32x16 o[4] = {};
    const int sr = tid >> 4, sc = (tid & 15) * 8, vst0 = v_st(sr, sc), vst1 = v_st(32 + sr, sc), kws = KSWZ(sr, sc * 2);
    const int rr8 = tid >> 3, rc8 = (tid & 7) * 8, kws2 = KSWZ(rr8, (128 + rc8) * 2);
    const int vb0 = (int)(uintptr_t)V_lds + v_rd_base(lane);
    const bf16* Kh = cur.K; const bf16* Vh = cur.V; const bf16* KRh = cur.KR;
#define RESC(a) do { if (__any((a) < 1.f)) { if (hi == 0) al_l[r32] = (a); asm volatile("s_waitcnt lgkmcnt(0)" ::: "memory");              \
                     for (int d_ = 0; d_ < 4; ++d_) for (int r = 0; r < 16; ++r) o[d_][r] *= al_l[crow(r, hi)]; } } while (0)
#define KBASE(t) ((t) * KVBLK)
#define MASKT(P0_, P1_, t) do { const int kb_ = KBASE(t); if (kb_ + KVBLK - 1 > qlo) mask_tile(P0_, P1_, qm - kb_, (unsigned)W); } while (0)
    constexpr int NQL = NQR;
#define SEAM_K0() do { VMWN(NQL); SWRITE_HK(0); SBAR(); } while (0)
    f32x16 pA0, pA1, pB0, pB1; float mnA, mnB, alA, alB; bf16x8 pa0, pa1, pa2, pa3;
    SWRITE_HV(0); SBAR();
    if (NT > 1) { SLOAD_H(Kh, Vh, KRh, KBASE(1)); }
    SBAR(); qkt<0>(pA0, pA1, K_lds, r32, hi, S.qr, qrope);
    MASKT(pA0, pA1, 0); partialSM(pA0, pA1, m_reg, mnA, alA);
    if (NT > 1) { VMW(); SWRITE_H(1); }
    __syncthreads();
    int vr = 0;
#define HALF_STEP(PX0, PX1, mnX, alX, PY0, PY1, alY, t, KB, SB) do {                                                          \
        const int vw_ = vr >= 1 ? vr - 1 : 2;                                                                 \
        SBAR(); qkt<KB>(PX0, PX1, K_lds, r32, hi, S.qr, qrope);                                                               \
        finishSM(PY0, PY1, alY, l_reg, pa0, pa1, pa2, pa3); SBAR();                                                           \
        if ((t) + 1 < NT) { SLOAD_H(Kh, Vh, KRh, KBASE((t) + 1)); SBAR(); }                                                   \
        pv_tile<0>(o, vb0 + vr * SHM_V, pa0, pa1, pa2, pa3); MASKT(PX0, PX1, (t)); partialSM(PX0, PX1, m_reg, mnX, alX);      \
        if ((t) + 1 < NT) { VMW(); SWRITE_HK(SB); SWRITE_HV(vw_); }                                                           \
        RESC(alX); __syncthreads();                                                                                           \
        vr = vr == 2 ? 0 : vr + 1; } while (0)
    for (int t = 1; t + 1 < NT; t += 2) {
        HALF_STEP(pB0, pB1, mnB, alB, pA0, pA1, alA, t, 1, 0);
        HALF_STEP(pA0, pA1, mnA, alA, pB0, pB1, alB, t + 1, 0, 1);
    }
    const bool even = (NT & 1) == 0;
    if (even) { SBAR(); qkt<1>(pB0, pB1, K_lds, r32, hi, S.qr, qrope); SBAR(); }
    const bf16* nqrow;
    { const BlockRef nxt = mk_ref(T, bhn, qbn);
      SLOAD_H(nxt.K, nxt.V, nxt.KR, 0); SBAR();
      nqrow = nxt.Q + (size_t)(wid * QBLK + r32) * QS + hi * 8; }
#pragma unroll
    for (int d0 = 0; d0 < NQR; ++d0) S.qr[d0] = load8(nqrow + d0 * 16);
    SBAR();
    finishSM(pA0, pA1, alA, l_reg, pa0, pa1, pa2, pa3); SBAR();
    pv_tile<0>(o, vb0 + vr * SHM_V, pa0, pa1, pa2, pa3);
    if (even) { MASKT(pB0, pB1, NT - 1); partialSM(pB0, pB1, m_reg, mnB, alB); __syncthreads(); RESC(alB);
        finishSM(pB0, pB1, alB, l_reg, pa0, pa1, pa2, pa3); SBAR(); pv_tile<0>(o, vb0 + (vr == 2 ? 0 : vr + 1) * SHM_V, pa0, pa1, pa2, pa3); }
    SBAR(); SEAM_K0();
    if (hi == 0) li_l[r32] = l_reg; asm volatile("s_waitcnt lgkmcnt(0)" ::: "memory");
    float rli[16];
#pragma unroll
    for (int r = 0; r < 16; ++r) rli[r] = __builtin_amdgcn_rcpf(li_l[crow(r, hi)]);
    bf16* Ow = mk_ref(T, bh, qb).O + (size_t)(wid * QBLK) * OS;
#pragma unroll
    for (int r = 0; r < 16; ++r) { const int orow = crow(r, hi);
#pragma unroll
        for (int d0 = 0; d0 < 4; ++d0) { const float v = o[d0][r] * rli[r];
            const float vn = __shfl_xor(v, 1);
            if ((r32 & 1) == 0) *(unsigned*)(Ow + (size_t)orow * OS + d0 * 32 + r32) = cvtpk(v, vn); } }
#pragma unroll
    for (int d0 = NQR; d0 < 12; ++d0) *(bf16x8*)(qrope + (d0 - NQR) * 1024) = load8(nqrow + d0 * 16);
    __syncthreads();
#undef RESC
#undef KBASE
#undef MASKT
#undef SEAM_K0
#undef HALF_STEP
}
#undef ROWK
#undef VMW
#undef VMWN
#undef LBAR
#undef SLOAD_H
#undef SWRITE_HK
#undef SWRITE_HV
#undef SWRITE_H
__device__ __forceinline__ void attn_phase(char* lds, const Tensors& T, int G, int vcu, int wave_id) {
    constexpr int NX = NQB / 2, TOTAL = 64 * NX;
    int L = vcu; if (L >= TOTAL) return;
    int bh = L / NX, x = L % NX, pass = 0;
    Seam S;
    { const BlockRef c0 = mk_ref(T, bh, x); attn_prime(c0, lds, S, wave_id); }
#pragma nounroll
    for (;;) {
        const bool more_pass = pass == 0, more_item = L + G < TOTAL, last = !more_pass && !more_item;
        int bhn = bh, xn = x, passn = pass + 1, Ln = L;
        if (!more_pass) { passn = 0; Ln = more_item ? L + G : L; bhn = Ln / NX; xn = Ln % NX; }
        const int qb = pass ? NQB - 1 - x : x, qbn = last ? qb : (passn ? NQB - 1 - xn : xn);
        attn_block(T, bh, qb, last ? bh : bhn, qbn, lds, S, wave_id);
        if (last) break;
        bh = bhn; x = xn; pass = passn; L = Ln;
    }
}
}

constexpr int NWAVES = 8;
constexpr int BATCH = 8, SEQ = 4096, D = 1024, FF = 4096, M = BATCH * SEQ;
constexpr int NG = 64, NP = 64, CH = 32, NCH = SEQ / CH, XG_LD = 640, RPG = BATCH * NCH;
constexpr float LN_EPS = 1e-5f, RMS_EPS = 1e-6f, DN_ALPHA = 1.4142135623730951f;
constexpr size_t MiB = 1u << 20;
constexpr size_t WS_WGLU = 1 * MiB, WS_WOUT = 5 * MiB, WS_W1 = 7 * MiB, WS_W2 = 23 * MiB, WS_WQKVA = 39 * MiB, WS_WKVB = 41 * MiB, WS_WQB = 42 * MiB, WS_WO = 44 * MiB;
constexpr size_t WS_W1G = 46 * MiB, WS_TG = 55 * MiB, WS_KBUF = 95 * MiB, WS_AL = 97 * MiB, WS_XG = 98 * MiB, WS_E = 178 * MiB, WS_YACT = 210 * MiB, WS_G = 274 * MiB;
constexpr size_t WS_HB = 400 * MiB, WS_HID = 98 * MiB;
constexpr size_t WS_CQKV = 98 * MiB, WS_CKV = 194 * MiB, WS_CQ = 210 * MiB, WS_KR = 234 * MiB, WS_CS = 238 * MiB, WS_KV = 246 * MiB, WS_Q = 374 * MiB, WS_O = 98 * MiB;
constexpr size_t WS_XBUF = 470 * MiB, WS_END = 472 * MiB;
constexpr size_t CTL_CNT = 65536, CTL_SSQ = 262144, CTL_ZERO_BYTES = 524288;
constexpr int LDS_BYTES = 153600, MISC_OFF = 153600 - 1024, LNTAB_OFF = 131072;
static_assert(att::LDS_BYTES <= MISC_OFF && pg8::STAGE_BYTES <= MISC_OFF, "LDS map");

#define GAS __attribute__((address_space(1)))
#define LAS __attribute__((address_space(3)))
typedef unsigned short bf16;
typedef unsigned v4u __attribute__((ext_vector_type(4)));
typedef unsigned v2u __attribute__((ext_vector_type(2)));
typedef float f32x4 __attribute__((ext_vector_type(4)));
typedef float f32x2 __attribute__((ext_vector_type(2)));
#define LDS_WAIT() asm volatile("s_waitcnt lgkmcnt(0)" ::: "memory")
__device__ __forceinline__ unsigned f2bf(float f) { unsigned u = __builtin_bit_cast(unsigned, f); return (u + 0x7fffu + ((u >> 16) & 1u)) >> 16; }
__device__ __forceinline__ unsigned pk2(float lo, float hi) { return f2bf(lo) | (f2bf(hi) << 16); }
__device__ __forceinline__ float wave_sum(float v) {
#pragma unroll
    for (int o = 1; o < 64; o <<= 1) v += __shfl_xor(v, o);
    return v;
}
__device__ __forceinline__ void sincos_red(float ang, float& s, float& c) {
    const float n = rintf(ang * 0.15915494309189535f);
    float r = fmaf(-n, 6.2831854820251465f, ang); r = fmaf(-n, -1.7484556e-7f, r);
    s = sinf(r); c = cosf(r);
}
__device__ __forceinline__ void cpow_a(float lrdt, float lidt, float k, float& re, float& im) {
    const float mag = expf(k * lrdt); float s, c; sincos_red(k * lidt, s, c); re = mag * c; im = mag * s;
}


__device__ __forceinline__ const void* argp(volatile LAS unsigned* misc, int i) {
    const unsigned lo = __builtin_amdgcn_readfirstlane(misc[16 + 2 * i]), hi = __builtin_amdgcn_readfirstlane(misc[16 + 2 * i + 1]);
    return (const void*)(((unsigned long long)hi << 32) | lo);
}
#define XB_TMO      128
#define XB_XCNT(j)  (256  + 64 * (j))
#define XB_XSUB(j)  (1280 + 64 * (j))
#define XB_XGEN(j)  (2304 + 64 * (j))
#define XB_TOP      3328
#define XB_TOPGEN   3392
#define XCD_BAR_WORDS 3456
#define XB_SPIN_CAP (1u << 22)
__device__ __forceinline__ unsigned xb_ld(unsigned* p)              { return __hip_atomic_load(p, __ATOMIC_RELAXED, __HIP_MEMORY_SCOPE_AGENT); }
__device__ __forceinline__ unsigned xb_add(unsigned* p, unsigned v) { return __hip_atomic_fetch_add(p, v, __ATOMIC_RELAXED, __HIP_MEMORY_SCOPE_AGENT); }
__device__ __forceinline__ unsigned xb_xcc_id() { return (unsigned)__builtin_amdgcn_s_getreg((3 << 11) | 20) & 0xFu; }
#define XB_SPIN(cond, bar) do { unsigned _sp = 0; while (cond) { __builtin_amdgcn_s_sleep(1); \
    if ((++_sp & 255u) == 0u) { if (xb_ld(&(bar)[XB_TMO])) break; if (_sp > XB_SPIN_CAP) { atomicAdd(&(bar)[XB_TMO], 1u); break; } } } } while (0)
struct XcdBarrier { unsigned* bar; unsigned x; volatile LAS unsigned* st; };
__device__ __forceinline__ XcdBarrier xcd_barrier_post(unsigned* bar, volatile LAS unsigned* st) {
    XcdBarrier b; b.bar = bar; b.x = xb_xcc_id(); b.st = st;
    if (threadIdx.x == 0) (void)xb_add(&bar[XB_XCNT(b.x)], 1u);
    return b;
}
__device__ __forceinline__ void xcd_barrier_complete(unsigned* bar, unsigned x, unsigned& nloc, unsigned& nx) {
    const unsigned G = gridDim.x * gridDim.y * gridDim.z;
    unsigned sum, cnt, mine, sp = 0u;
    for (;;) {
        sum = 0u; cnt = 0u; mine = 0u;
#pragma unroll
        for (unsigned j = 0; j < 16; ++j) { const unsigned c = xb_ld(&bar[XB_XCNT(j)]); sum += c; cnt += (c > 0u) ? 1u : 0u; mine = (j == x) ? c : mine; }
        if (sum == G) break;
        __builtin_amdgcn_s_sleep(1);
        if ((++sp & 255u) == 0u) { if (xb_ld(&bar[XB_TMO])) break; if (sp > XB_SPIN_CAP) { atomicAdd(&bar[XB_TMO], 1u); break; } }
    }
    nloc = mine > 0u ? mine : 1u; nx = cnt > 0u ? cnt : 1u;
}
__device__ __forceinline__ void xcd_barrier(volatile LAS unsigned* misc, int wave_id) {
    asm volatile("s_waitcnt vmcnt(0)" ::: "memory");
    __syncthreads();
    if (wave_id == 0 && lane_id() == 0) {
        XcdBarrier b; b.bar = (unsigned*)argp(misc, 26); b.x = misc[10]; b.st = misc + 8;
        unsigned* bar = b.bar;
        __builtin_amdgcn_s_waitcnt(0);
        unsigned nloc = b.st[0], nx = b.st[1];
        if (nloc == 0u) { xcd_barrier_complete(bar, b.x, nloc, nx); b.st[0] = nloc; b.st[1] = nx; }
        const unsigned old = xb_add(&bar[XB_XSUB(b.x)], 1u);
        const unsigned gen = old / nloc;
        if (old + 1u == (gen + 1u) * nloc) {
            __builtin_amdgcn_fence(__ATOMIC_RELEASE, "agent");
            asm volatile("s_waitcnt vmcnt(0)" ::: "memory");
            const unsigned og = xb_add(&bar[XB_TOP], 1u);
            const unsigned tg = og / nx;
            if (og + 1u == (tg + 1u) * nx) xb_add(&bar[XB_TOPGEN], 1u);
            else XB_SPIN(xb_ld(&bar[XB_TOPGEN]) == tg, bar);
            __builtin_amdgcn_fence(__ATOMIC_ACQUIRE, "agent");
            xb_add(&bar[XB_XGEN(b.x)], 1u);
            asm volatile("s_waitcnt vmcnt(0)" ::: "memory");
        } else {
            XB_SPIN(xb_ld(&bar[XB_XGEN(b.x)]) == gen, bar);
            __builtin_amdgcn_fence(__ATOMIC_ACQUIRE, "agent");
            asm volatile("s_waitcnt vmcnt(0)" ::: "memory");
        }
    }
    __syncthreads();
}

__device__ __forceinline__ void cpow_fast(float lrdt, float lidt, float k, float& re, float& im) {
    const float mag = __expf(k * lrdt), ang = k * lidt, n = rintf(ang * 0.15915494309189535f);
    float r = fmaf(-n, 6.2831854820251465f, ang); r = fmaf(-n, -1.7484556e-7f, r);
    re = mag * __cosf(r); im = mag * __sinf(r);
}
struct Args { const void* in[25]; float* out; unsigned char* ws; };
__device__ __forceinline__ int launder_s(int v) { asm volatile("" : "+s"(v)); return v; }
__device__ __forceinline__ int launder(int v) { asm volatile("" : "+v"(v)); return v; }

__device__ __forceinline__ int map_row(int mode, int n0) {
    if (mode == 0) return n0;
    if (mode == 1) { const int gate = n0 >= 1024, c = gate ? n0 - 1024 : n0; return 256 * (c >> 7) + (gate ? 128 : 0) + (c & 127); }
    if (mode == 3) return n0 < 256 ? n0 : (n0 == 256 ? 768 : 896);
    const int h = n0 / 192, d = n0 % 192;
    if (d < 128) return h * 128 + d;
    const int half = d >= 160, i = d - 128 - 32 * half;
    return 1024 + (h >> 2) * 256 + half * 128 + (h & 3) * 32 + i;
}
__device__ __forceinline__ void transpose_item(const float* W, int K, int N, bf16* WT, int row_off, int mode, LAS float* scr, int item, int lane, const float* kgain = nullptr) {
    const int nblk = N / 32, kb = item / nblk, nb = item % nblk, k0 = 64 * kb, n0 = 32 * nb;
    float tv[32];
#pragma unroll
    for (int i = 0; i < 32; ++i) tv[i] = W[(size_t)(k0 + 2 * i + (lane >> 5)) * N + n0 + (lane & 31)];
    if (kgain) {
#pragma unroll
        for (int i = 0; i < 32; ++i) tv[i] *= kgain[k0 + 2 * i + (lane >> 5)]; }
#pragma unroll
    for (int i = 0; i < 32; ++i) scr[(2 * i + (lane >> 5)) * 33 + (lane & 31)] = tv[i];
    LDS_WAIT(); asm volatile("" ::: "memory");
    const int c = lane & 7, r0 = row_off + map_row(mode, n0);
#pragma unroll
    for (int j = 0; j < 4; ++j) { const int n = (lane >> 3) + 8 * j; const LAS float* s = scr + (8 * c) * 33 + n;
        v4u o; o.x = pk2(s[0 * 33], s[1 * 33]); o.y = pk2(s[2 * 33], s[3 * 33]); o.z = pk2(s[4 * 33], s[5 * 33]); o.w = pk2(s[6 * 33], s[7 * 33]);
        *(v4u*)(WT + (size_t)(r0 + n) * K + k0 + 8 * c) = o; }
    LDS_WAIT(); asm volatile("" ::: "memory");
}
__device__ __forceinline__ void ln_row(float* row, bf16* orow, const float* g, const float* b, int lane) {
    f32x4* xr = (f32x4*)row + lane;
    f32x4 v[4]; float s = 0.f;
#pragma unroll
    for (int j = 0; j < 4; ++j) { v[j] = xr[64 * j]; s += (v[j].x + v[j].y) + (v[j].z + v[j].w); }
    const float mean = wave_sum(s) * (1.f / D); float s2 = 0.f;
#pragma unroll
    for (int j = 0; j < 4; ++j) { v[j] = v[j] - mean; s2 += (v[j].x * v[j].x + v[j].y * v[j].y) + (v[j].z * v[j].z + v[j].w * v[j].w); }
    const float rstd = 1.f / sqrtf(wave_sum(s2) * (1.f / D) + LN_EPS);
#pragma unroll
    for (int j = 0; j < 4; ++j) { const f32x4 gg = *((const f32x4*)g + lane + 64 * j), bb = *((const f32x4*)b + lane + 64 * j);
        const f32x4 y = v[j] * rstd * gg + bb; xr[64 * j] = y;
        if (orow) { v2u w; w.x = pk2(y.x, y.y); w.y = pk2(y.z, y.w); *((v2u*)orow + lane + 64 * j) = w; } }
}

__global__ void __launch_bounds__(NWAVES * 64, 2) mega_fwd(Args args) {
    extern __shared__ __attribute__((aligned(16))) unsigned char lds[];
    cg::grid_group grid = cg::this_grid();
    LAS unsigned char* ldsl = (LAS unsigned char*)lds;
    const int wave = __builtin_amdgcn_readfirstlane((int)threadIdx.x >> 6);
#define tid ((wave << 6) | lane_id())
#define lane0 lane_id()
    const int G = gridDim.x, bx = blockIdx.x;
    const int vcu = (G % 8 == 0) ? (bx % 8) * (G / 8) + bx / 8 : bx;
    const int gw = vcu * NWAVES + wave, NGW = G * NWAVES;
    volatile LAS unsigned* MISC = (volatile LAS unsigned*)(ldsl + MISC_OFF);
    if (tid < 16) MISC[tid] = 0u;
    if (tid == 0) {
        volatile LAS unsigned long long* A = (volatile LAS unsigned long long*)(MISC + 16);
#pragma unroll
        for (int i = 0; i < 25; ++i) A[i] = (unsigned long long)args.in[i];
        A[25] = (unsigned long long)args.out; A[26] = (unsigned long long)args.ws;
    }
    __syncthreads();
    { const XcdBarrier xb0 = xcd_barrier_post((unsigned*)args.ws, MISC + 8); if (tid == 0) MISC[10] = xb0.x; }
    int n_stamp = 0;
#define STAMP() do { if (PROBE_HI > 0) { if (bx == 0 && tid == 0) ((volatile LAS unsigned long long*)(MISC + 128))[n_stamp] = __builtin_amdgcn_s_memrealtime(); ++n_stamp; } } while (0)
#define BAR() do { xcd_barrier(MISC, wave); STAMP(); } while (0)
    STAMP();
    if (gridDim.y == 7) grid.sync();
#define ARGF(i) ((const float*)argp(MISC, (i)))
#define WSP(T, off) ((T*)((unsigned char*)argp(MISC, 26) + (off)))
#define x_in ARGF(0)
#define positions ((const int*)argp(MISC, 1))
#define ln_mix_g ARGF(2)
#define ln_mix_b ARGF(3)
#define ln_ffn_g ARGF(4)
#define ln_ffn_b ARGF(5)
#define w_ff1 ARGF(6)
#define w_ff2 ARGF(7)
#define lam_re ARGF(8)
#define lam_im ARGF(9)
#define log_dt ARGF(10)
#define b_re ARGF(11)
#define b_im ARGF(12)
#define c_re ARGF(13)
#define c_im ARGF(14)
#define ssm_d ARGF(15)
#define w_glu ARGF(16)
#define w_out ARGF(17)
#define kv_w_a ARGF(18)
#define kv_norm_g ARGF(19)
#define kv_w_b ARGF(20)
#define q_w_a ARGF(21)
#define q_norm_g ARGF(22)
#define q_w_b ARGF(23)
#define attn_w_o ARGF(24)
#define R ((float*)argp(MISC, 25))
#define Wglu_t WSP(bf16, WS_WGLU)
#define Wout_t WSP(bf16, WS_WOUT)
#define W1_t WSP(bf16, WS_W1)
#define W2_t WSP(bf16, WS_W2)
#define Wqkva_t WSP(bf16, WS_WQKVA)
#define Wkvb_t WSP(bf16, WS_WKVB)
#define Wqb_t WSP(bf16, WS_WQB)
#define Wo_t WSP(bf16, WS_WO)
#define W1g WSP(bf16, WS_W1G)
#define Tg WSP(bf16, WS_TG)
#define Kbuf WSP(float, WS_KBUF)
#define AL WSP(float, WS_AL)
#define Xg WSP(bf16, WS_XG)
#define Ebuf WSP(float, WS_E)
#define Yact WSP(bf16, WS_YACT)
#define Gb WSP(bf16, WS_G)
#define Hb WSP(bf16, WS_HB)
#define HID WSP(bf16, WS_HID)
#define CQKV WSP(float, WS_CQKV)
#define CKV WSP(bf16, WS_CKV)
#define CQ WSP(bf16, WS_CQ)
#define KR WSP(bf16, WS_KR)
#define CS ((float*)argp(MISC, 25) + (size_t)24 * 1024 * 1024)
#define SSQ_KV WSP(float, CTL_SSQ)
#define SSQ_Q WSP(float, CTL_SSQ + 131072)
#define KV WSP(bf16, WS_KV)
#define Qb ((bf16*)argp(MISC, 25))
#define Ob WSP(bf16, WS_O)

#pragma nounroll
    for (int rep0_ = 0; rep0_ < (PROBE == 4 ? 2 : 1); ++rep0_) {
        const int lane = launder(lane0);
        LAS float* scr = (LAS float*)(ldsl + wave * 16384);
        constexpr int I_GLU = 16 * 64, I_OUT = 16 * 32, I_F1 = 16 * 128, I_F2 = 64 * 32, I_KVA = 16 * 10, I_QA = 16 * 12, I_KVB = 4 * 64, I_QB = 6 * 48, I_WO = 16 * 32;
        constexpr int NT_ITEMS = I_GLU + I_OUT + 2 * I_F1 + 2 * I_F2 + I_KVA + I_QA + I_KVB + I_QB + I_WO;
        for (int it = gw; it < NT_ITEMS; it += NGW) {
            int r = it;
            if (r < I_GLU) { transpose_item(w_glu, 1024, 2048, Wglu_t, 0, 1, scr, r, lane); continue; } r -= I_GLU;
            if (r < I_OUT) { transpose_item(w_out, 1024, 1024, Wout_t, 0, 0, scr, r, lane); continue; } r -= I_OUT;
            if (r < I_F1) { transpose_item(w_ff1, 1024, 4096, W1_t, 0, 0, scr, r, lane); continue; } r -= I_F1;
            if (r < I_F1) { transpose_item(w_ff1 + (size_t)1024 * 4096, 1024, 4096, W1_t + (size_t)4096 * 1024, 0, 0, scr, r, lane); continue; } r -= I_F1;
            if (r < I_F2) { transpose_item(w_ff2, 4096, 1024, W2_t, 0, 0, scr, r, lane); continue; } r -= I_F2;
            if (r < I_F2) { transpose_item(w_ff2 + (size_t)4096 * 1024, 4096, 1024, W2_t + (size_t)1024 * 4096, 0, 0, scr, r, lane); continue; } r -= I_F2;
            if (r < I_KVA) { transpose_item(kv_w_a, 1024, 320, Wqkva_t, 0, 3, scr, r, lane); continue; } r -= I_KVA;
            if (r < I_QA) { transpose_item(q_w_a, 1024, 384, Wqkva_t, 256, 0, scr, r, lane); continue; } r -= I_QA;
            if (r < I_KVB) { transpose_item(kv_w_b, 256, 2048, Wkvb_t, 0, 0, scr, r, lane, kv_norm_g); continue; } r -= I_KVB;
            if (r < I_QB) { transpose_item(q_w_b, 384, 1536, Wqb_t, 0, 2, scr, r, lane, q_norm_g); continue; } r -= I_QB;
            transpose_item(attn_w_o, 1024, 1024, Wo_t, 0, 0, scr, r, lane);
        }
        for (int i = gw * 64 + lane; i < 320 * 128; i += NGW * 64) { const int ri = i >> 7, ch = i & 127, row = ri < 128 ? 640 + ri : (ri < 224 ? 800 + (ri - 128) : 928 + (ri - 224));
            *((v4u*)(Wqkva_t + (size_t)row * 1024) + ch) = (v4u){0u, 0u, 0u, 0u}; }
        for (int i = gw * 64 + lane; i < 8192; i += NGW * 64) *((v4u*)(W1g + (size_t)NG * 128 * 512) + i) = (v4u){0u, 0u, 0u, 0u};
        for (int it = gw; it < 4096 + 2048 + 2048 + 64; it += NGW) {
            if (it < 4096) {
                const int g = it >> 6, p = it & 63;
                const float lr = lam_re[g * 64 + p], li = lam_im[g * 64 + p], dt = expf(log_dt[g]), lrdt = lr * dt, lidt = li * dt;
                float are, aim; cpow_a(lrdt, lidt, 1.f, are, aim);
                const float inv = 1.0f / (lr * lr + li * li), cre = ((are - 1.0f) * lr + aim * li) * inv, cim = (aim * lr - (are - 1.0f) * li) * inv;
                const int c = lane & 15;
                const float br = b_re[(size_t)(g * 64 + p) * 16 + c], bi = b_im[(size_t)(g * 64 + p) * 16 + c];
                const float bbre = cre * br - cim * bi, bbim = cre * bi + cim * br;
#pragma unroll
                for (int i = 0; i < 8; ++i) { const int s = (lane >> 4) + 4 * i; float pr, pi; cpow_fast(lrdt, lidt, (float)(31 - s), pr, pi);
                    W1g[(size_t)(g * 128 + p) * 512 + s * 16 + c] = (bf16)f2bf(pr * bbre - pi * bbim);
                    W1g[(size_t)(g * 128 + 64 + p) * 512 + s * 16 + c] = (bf16)f2bf(pr * bbim + pi * bbre); }
            } else if (it < 4096 + 2048) {
                const int r = it - 4096, g = r >> 5, j = r & 31;
                LAS float* sbr = scr; LAS float* sbi = scr + 1024; LAS float* scre = scr + 2048; LAS float* scim = scr + 3072;
#pragma unroll
                for (int q = 0; q < 4; ++q) { const int idx = (q * 64 + lane) * 4;
                    *(LAS f32x4*)(sbr + idx) = *(const f32x4*)(b_re + (size_t)g * 1024 + idx); *(LAS f32x4*)(sbi + idx) = *(const f32x4*)(b_im + (size_t)g * 1024 + idx);
                    *(LAS f32x4*)(scre + idx) = *(const f32x4*)(c_re + (size_t)g * 1024 + idx); *(LAS f32x4*)(scim + idx) = *(const f32x4*)(c_im + (size_t)g * 1024 + idx); }
                const int p = lane;
                const float lr = lam_re[g * 64 + p], li = lam_im[g * 64 + p], dt = expf(log_dt[g]), lrdt = lr * dt, lidt = li * dt;
                float are, aim; cpow_a(lrdt, lidt, 1.f, are, aim);
                const float inv = 1.0f / (lr * lr + li * li), cre = ((are - 1.0f) * lr + aim * li) * inv, cim = (aim * lr - (are - 1.0f) * li) * inv;
                float pr, pi; cpow_fast(lrdt, lidt, (float)j, pr, pi);
                const float zre = pr * cre - pi * cim, zim = pr * cim + pi * cre;
                LDS_WAIT(); asm volatile("" ::: "memory");
                const int ci = lane & 15, cog = lane >> 4;
                float acc4[4] = {0.f, 0.f, 0.f, 0.f};
#pragma unroll 8
                for (int pp = 0; pp < 64; ++pp) {
                    const float zr = __uint_as_float(__builtin_amdgcn_readlane(__float_as_uint(zre), pp)), zi = __uint_as_float(__builtin_amdgcn_readlane(__float_as_uint(zim), pp)), br = sbr[pp * 16 + ci], bi = sbi[pp * 16 + ci];
                    const float xr = zr * br - zi * bi, xi = zr * bi + zi * br;
#pragma unroll
                    for (int k = 0; k < 4; ++k) acc4[k] += scre[(cog + 4 * k) * 64 + pp] * xr - scim[(cog + 4 * k) * 64 + pp] * xi;
                }
#pragma unroll
                for (int k = 0; k < 4; ++k) { const int co = cog + 4 * k; float v = acc4[k]; if (j == 0 && co == ci) v += ssm_d[g * 16 + co];
                    const bf16 hv = (bf16)f2bf(v); bf16* tp = Tg + (size_t)(g * 512 + co) * XG_LD + ci;
                    for (int t = j; t < 32; ++t) tp[(size_t)t * 16 * XG_LD + (t - j) * 16] = hv;
                    for (int t = 0; t + j + 1 < 32; ++t) tp[(size_t)t * 16 * XG_LD + (t + j + 1) * 16] = (bf16)0; }
                LDS_WAIT(); asm volatile("" ::: "memory");
            } else if (it < 4096 + 4096) {
                const int r = it - 6144, g = r >> 5, t = r & 31, p = lane;
                const float lr = lam_re[g * 64 + p], li = lam_im[g * 64 + p], dt = expf(log_dt[g]);
                float pr, pi; cpow_fast(lr * dt, li * dt, (float)(t + 1), pr, pi);
#pragma unroll 4
                for (int co = 0; co < 16; ++co) { const float cr = c_re[(size_t)(g * 16 + co) * 64 + p], cim_ = c_im[(size_t)(g * 16 + co) * 64 + p];
                    bf16* rowp = Tg + (size_t)(g * 512 + t * 16 + co) * XG_LD + 512;
                    rowp[p] = (bf16)f2bf(cr * pr - cim_ * pi); rowp[64 + p] = (bf16)f2bf(-(cr * pi + cim_ * pr)); }
            } else {
                const int g = it - 8192, p = lane;
                const float lr = lam_re[g * 64 + p], li = lam_im[g * 64 + p], dt = expf(log_dt[g]);
                float pr, pi; cpow_a(lr * dt, li * dt, 32.f, pr, pi);
                AL[(g * 64 + p) * 2] = pr; AL[(g * 64 + p) * 2 + 1] = pi;
            }
        }
#define XLOAD(V, T0) do { _Pragma("unroll") for (int q = 0; q < 4; ++q) { const f32x4* src = (const f32x4*)(x_in + (size_t)((T0) + q) * D + lane * 16); \
            _Pragma("unroll") for (int e = 0; e < 4; ++e) V[q][e] = src[e]; } } while (0)
#define XPROC(V, T0) do {                                                                                                                          \
            {                                     \
                const int q = lane >> 4, i2 = (lane & 15) * 2; const float pos = (float)positions[(T0) + q];                                    \
                float sn0, cs0, sn1, cs1;                                                                                                       \
                sincos_red(pos * exp2f(-(float)i2 * (13.287712379549449f / 32.0f)), sn0, cs0); sincos_red(pos * exp2f(-(float)(i2 + 1) * (13.287712379549449f / 32.0f)), sn1, cs1); \
                float* cp = CS + (size_t)((T0) + q) * 64 + i2; *(f32x2*)cp = (f32x2){cs0, cs1}; *(f32x2*)(cp + 32) = (f32x2){sn0, sn1}; }        \
            _Pragma("unroll") for (int q = 0; q < 4; ++q) { const int tok = (T0) + q;                                                           \
                v4u o0, o1; o0.x = pk2(V[q][0].x, V[q][0].y); o0.y = pk2(V[q][0].z, V[q][0].w); o0.z = pk2(V[q][1].x, V[q][1].y); o0.w = pk2(V[q][1].z, V[q][1].w); \
                o1.x = pk2(V[q][2].x, V[q][2].y); o1.y = pk2(V[q][2].z, V[q][2].w); o1.z = pk2(V[q][3].x, V[q][3].y); o1.w = pk2(V[q][3].z, V[q][3].w); \
                v4u* dst = (v4u*)(Xg + ((size_t)lane * RPG + (tok >> 5)) * XG_LD + (tok & 31) * 16);                                            \
                dst[0] = o0; dst[1] = o1; } } while (0)
        {
            const int step = NGW * 4; int tok0 = gw * 4;
            f32x4 va[4][4], vb[4][4];
            if (tok0 < M) XLOAD(va, tok0);
            while (tok0 < M) {
                const int t1 = tok0 + step; if (t1 < M) XLOAD(vb, t1);
                XPROC(va, tok0);
                if (t1 >= M) break;
                const int t2 = t1 + step; if (t2 < M) XLOAD(va, t2);
                XPROC(vb, t1);
                tok0 = t2;
            }
        }
#undef XLOAD
#undef XPROC
    }
    BAR();
    {
        const int unit_ = launder_s(vcu);
        {
            pg8::Gemm g{Xg, W1g, 512, XG_LD, 512, (unsigned)(256 * XG_LD * 2), (unsigned)(128 * 512 * 2)};
            pg8::BatchOrder S; S.init(NG, 4, 1, G, unit_);
            pg8::EpiS1Scan E{Xg, AL};
            pg8::gemm_phase<pg8::EpiS1Scan, pg8::BatchOrder, false>(ldsl, g, S, E, wave);
        }
        __syncthreads(); __builtin_amdgcn_fence(__ATOMIC_ACQUIRE, "agent");
        if (unit_ < NG * 4) {
            pg8::Gemm g{Xg, Tg, XG_LD, XG_LD, XG_LD, (unsigned)(256 * XG_LD * 2), (unsigned)(256 * XG_LD * 2)};
            pg8::PairOrder S{unit_};
            pg8::EpiBf16<2> E{Yact, 512, 128, nullptr, 0.f, 1};
            pg8::gemm_phase<pg8::EpiBf16<2>, pg8::PairOrder, true>(ldsl, g, S, E, wave);
        }
    }
    BAR();
    {
        pg8::Gemm g{Yact, Wglu_t, 1024, 1024, 1024, (unsigned)(256 * 16 * 2), (unsigned)(256 * 1024 * 2), (unsigned)(M * 16)};
        pg8::StaticOrder S; S.init(M, 2048, G, launder_s(bx));
        pg8::EpiGlu E{Gb, 1024};
        pg8::gemm_phase<pg8::EpiGlu, pg8::StaticOrder, true>(ldsl, g, S, E, wave);
    }
    BAR();
    static_assert(LNTAB_OFF >= pg8::STAGE_BYTES && LNTAB_OFF + 10240 + 16 <= MISC_OFF, "LDS map");
#define RES_LN_GEMM(Aptr, Btptr, Kdim, BASE_BF16, OUT_F32, BASEPTR, OUTPTR, GAM, BET, BANK, ENDBAR) do {                                             \
            {   pg8::Gemm g{Aptr, Btptr, Kdim, Kdim, Kdim, (unsigned)(256 * (Kdim) * 2), (unsigned)(256 * (Kdim) * 2)};                         \
                pg8::StaticOrder S; S.init(M, 1024, G, launder_s(bx));                                                                          \
                pg8::PanelStats st{(unsigned*)WSP(unsigned char, WS_XBUF), (unsigned*)WSP(unsigned char, CTL_CNT + (size_t)(BANK) * 32768), LN_EPS}; \
                pg8::EpiResLn<BASE_BF16, OUT_F32> E{BASEPTR, OUTPTR, GAM, BET, DN_ALPHA, st, ldsl + LNTAB_OFF};                                 \
                pg8::gemm_phase<pg8::EpiResLn<BASE_BF16, OUT_F32>, pg8::StaticOrder, true>(ldsl, g, S, E, wave);                                \
            }                                                                                                                                   \
            if (ENDBAR) BAR();                                                                                                                  \
        } while (0)
    RES_LN_GEMM(Gb, Wout_t, 1024, 2, false, Xg, Hb, ln_mix_g, ln_mix_b, 0, true);
    {
        constexpr int layer = 0;
        {
            pg8::Gemm g{Hb, W1_t + (size_t)layer * 4096 * 1024, 1024, 1024, 1024, (unsigned)(256 * 1024 * 2), (unsigned)(256 * 1024 * 2)};
            pg8::StaticOrder S; S.init(M, 4096, G, launder_s(bx));
            pg8::EpiBf16<1> E{HID, 4096, 128, nullptr, 0.f};
            pg8::gemm_phase<pg8::EpiBf16<1>, pg8::StaticOrder, true>(ldsl, g, S, E, wave);
        }
        BAR();
        if constexpr (layer == 0) RES_LN_GEMM(HID, W2_t, 4096, 1, false, Hb, Hb, ln_ffn_g, ln_ffn_b, 1, true);
        else RES_LN_GEMM(HID, W2_t + (size_t)1024 * 4096, 4096, 1, true, Hb, R, ln_ffn_g + D, ln_ffn_b + D, 3, false);
        }
    {
            {
                pg8::Gemm g{Hb, Wqkva_t, 1024, 1024, 1024, (unsigned)(256 * 1024 * 2), (unsigned)(256 * 1024 * 2)};
                pg8::StaticOrder S; S.init(M, 1024, G, launder_s(bx));
                pg8::EpiQKVA E{CKV, CQ, KR, CS, SSQ_KV, SSQ_Q};
                pg8::gemm_phase<pg8::EpiQKVA, pg8::StaticOrder, true>(ldsl, g, S, E, wave);
            }
            BAR();
            if ((vcu & 1) == 0) {
            {
                pg8::Gemm g{CKV, Wkvb_t, 256, 256, 256, (unsigned)(256 * 256 * 2), (unsigned)(256 * 256 * 2)};
                pg8::StaticOrder S; S.init(M, 2048, G, launder_s(bx));
                pg8::EpiBf16<0> E{KV, 2048, 128, SSQ_KV, 1.0f / 256.0f};
                pg8::gemm_phase<pg8::EpiBf16<0>, pg8::StaticOrder, true>(ldsl, g, S, E, wave);
            }
            {
                pg8::Gemm g{CQ, Wqb_t, 384, 384, 384, (unsigned)(256 * 384 * 2), (unsigned)(256 * 384 * 2)};
                pg8::StaticOrder S; S.init(M, 1536, G, launder_s(bx));
                pg8::EpiQ E{Qb, CS, SSQ_Q};
                pg8::gemm_phase<pg8::EpiQ, pg8::StaticOrder, true>(ldsl, g, S, E, wave);
            }
            } else {
            {
                pg8::Gemm g{CQ, Wqb_t, 384, 384, 384, (unsigned)(256 * 384 * 2), (unsigned)(256 * 384 * 2)};
                pg8::StaticOrder S; S.init(M, 1536, G, launder_s(bx));
                pg8::EpiQ E{Qb, CS, SSQ_Q};
                pg8::gemm_phase<pg8::EpiQ, pg8::StaticOrder, true>(ldsl, g, S, E, wave);
            }
            {
                pg8::Gemm g{CKV, Wkvb_t, 256, 256, 256, (unsigned)(256 * 256 * 2), (unsigned)(256 * 256 * 2)};
                pg8::StaticOrder S; S.init(M, 2048, G, launder_s(bx));
                pg8::EpiBf16<0> E{KV, 2048, 128, SSQ_KV, 1.0f / 256.0f};
                pg8::gemm_phase<pg8::EpiBf16<0>, pg8::StaticOrder, true>(ldsl, g, S, E, wave);
            }
            }
            BAR();
            {
                const att::Tensors T{(const att::bf16*)Qb, (const att::bf16*)KV, (const att::bf16*)KR, (att::bf16*)Ob};
#pragma nounroll
                for (int rep_ = 0; rep_ < (PROBE == 1 ? 2 : 1); ++rep_) { if (rep_) BAR(); att::attn_phase((char*)lds, T, G, launder_s(vcu), wave); }
            }
            BAR();
#if PROBE == 2
            for (int i_ = 0; i_ < 20; ++i_) BAR();
#endif
            RES_LN_GEMM(Ob, Wo_t, 1024, 1, false, Hb, Hb, ln_mix_g + D, ln_mix_b + D, 2, true);
    }
    {
        constexpr int layer = 1;
        {
            pg8::Gemm g{Hb, W1_t + (size_t)layer * 4096 * 1024, 1024, 1024, 1024, (unsigned)(256 * 1024 * 2), (unsigned)(256 * 1024 * 2)};
            pg8::StaticOrder S; S.init(M, 4096, G, launder_s(bx));
            pg8::EpiBf16<1> E{HID, 4096, 128, nullptr, 0.f};
            pg8::gemm_phase<pg8::EpiBf16<1>, pg8::StaticOrder, true>(ldsl, g, S, E, wave);
        }
        BAR();
        if constexpr (layer == 0) RES_LN_GEMM(HID, W2_t, 4096, 1, false, Hb, Hb, ln_ffn_g, ln_ffn_b, 1, true);
        else RES_LN_GEMM(HID, W2_t + (size_t)1024 * 4096, 4096, 1, true, Hb, R, ln_ffn_g + D, ln_ffn_b + D, 3, false);
        }
#undef RES_LN_GEMM
    if (PROBE_HI > 0) {
        __syncthreads(); STAMP();
        if (bx == 0 && tid == 0) { volatile LAS unsigned long long* ST = (volatile LAS unsigned long long*)(MISC + 128);
            unsigned long long d = 0; for (int k = 0; k < 24; ++k) if ((PROBE_MASK >> k) & 1u) d += ST[k + 1] - ST[k];
            d *= PROBE_MULT; const unsigned long long t0 = __builtin_amdgcn_s_memrealtime();
            while (__builtin_amdgcn_s_memrealtime() - t0 < d) __builtin_amdgcn_s_sleep(8); }
    }
}

#undef ARGF
#undef WSP
#undef x_in
#undef positions
#undef ln_mix_g
#undef ln_mix_b
#undef ln_ffn_g
#undef ln_ffn_b
#undef w_ff1
#undef w_ff2
#undef lam_re
#undef lam_im
#undef log_dt
#undef b_re
#undef b_im
#undef c_re
#undef c_im
#undef ssm_d
#undef w_glu
#undef w_out
#undef kv_w_a
#undef kv_norm_g
#undef kv_w_b
#undef q_w_a
#undef q_norm_g
#undef q_w_b
#undef attn_w_o
#undef R
#undef Wglu_t
#undef Wout_t
#undef W1_t
#undef W2_t
#undef Wqkva_t
#undef Wkvb_t
#undef Wqb_t
#undef Wo_t
#undef W1g
#undef Tg
#undef Kbuf
#undef AL
#undef Xg
#undef Ebuf
#undef Yact
#undef Gb
#undef Hb
#undef HID
#undef CQKV
#undef CKV
#undef CQ
#undef KR
#undef CS
#undef SSQ_KV
#undef SSQ_Q
#undef KV
#undef Qb
#undef Ob
extern "C" void kernel_launch(void* const* d_in, const int* in_sizes, int n_in, void* d_out, int out_size, void* d_ws, size_t ws_size, hipStream_t stream) {
    static int grid = 0;
    if (grid == 0) {
        if (n_in != 25 || in_sizes[0] != M * D || out_size != M * D || ws_size < WS_END) { fprintf(stderr, "kernel_launch: unexpected shapes (n_in %d, in0 %d, out %d, ws %zu)\n", n_in, n_in > 0 ? in_sizes[0] : -1, out_size, ws_size); grid = -1; return; }
        int dev = 0, cus = 0, per_cu = 0;
        if (hipGetDevice(&dev) != hipSuccess || hipDeviceGetAttribute(&cus, hipDeviceAttributeMultiprocessorCount, dev) != hipSuccess) { grid = -1; return; }
        if (hipFuncSetAttribute((const void*)mega_fwd, hipFuncAttributeMaxDynamicSharedMemorySize, LDS_BYTES) != hipSuccess) { fprintf(stderr, "kernel_launch: hipFuncSetAttribute failed\n"); grid = -1; return; }
        if (hipOccupancyMaxActiveBlocksPerMultiprocessor(&per_cu, (const void*)mega_fwd, NWAVES * 64, LDS_BYTES) != hipSuccess || per_cu < 1) per_cu = 1;
        (void)hipGetLastError();
        grid = cus;
        if (grid != 256) { fprintf(stderr, "kernel_launch: this kernel needs exactly 256 workgroups (one per CU of a 256-CU device); found %d CUs; nothing launched\n", cus); grid = -1; return; }
    }
    if (grid < 0) return;
    if (hipMemsetAsync(d_ws, 0, CTL_ZERO_BYTES, stream) != hipSuccess) { fprintf(stderr, "kernel_launch: hipMemsetAsync failed\n"); return; }
    Args a{};
    for (int i = 0; i < 25; ++i) a.in[i] = d_in[i];
    a.out = (float*)d_out; a.ws = (unsigned char*)d_ws;
    void* kargs[] = {&a};
    hipError_t e = hipLaunchCooperativeKernel((const void*)mega_fwd, dim3(grid), dim3(NWAVES * 64), kargs, LDS_BYTES, stream);
    if (e != hipSuccess) fprintf(stderr, "kernel_launch: cooperative launch failed: %s (grid %d)\n", hipGetErrorString(e), grid);
}
```

```cpp
#include <hip/hip_runtime.h>
#include <hip/hip_bf16.h>
#include <hip/hip_cooperative_groups.h>
#include <cstdio>
#include <cstdint>
namespace cg = cooperative_groups;
#ifndef PROBE
#define PROBE 0
#endif
#define PROBE_MASK 0u
#define PROBE_HI (PROBE_MASK != 0u)
#define PROBE_MULT 4
__device__ __forceinline__ int lane_id() { int l; asm volatile("v_mbcnt_lo_u32_b32 %0, -1, 0\n\tv_mbcnt_hi_u32_b32 %0, -1, %0" : "=v"(l)); return l; }

namespace pg8 {
#define PG8_LAS __attribute__((address_space(3)))
typedef unsigned short bf16_t;
typedef short bf16x8 __attribute__((ext_vector_type(8)));
typedef float f32x4 __attribute__((ext_vector_type(4)));
typedef float f32x2 __attribute__((ext_vector_type(2)));
typedef unsigned u32x4 __attribute__((ext_vector_type(4)));
constexpr int BM = 256, BK = 64, HALF = 128, HTB = HALF * BK * 2, STAGE_BYTES = 8 * HTB, NXCD = 8, WGM = 8;

__host__ __device__ __forceinline__ int lds_byte(int r, int c) { const int st = (r >> 4) * 2 + (c >> 5), rr = r & 15, cc = c & 31, ob = rr * 64 + cc * 2; return st * 1024 + (ob ^ (((ob >> 9) & 1) << 5)); }
__host__ __device__ __forceinline__ void stage_rc(int b, int& R, int& C) { const int st = b / 1024, sb = b % 1024, swz = sb ^ (((sb >> 9) & 1) << 5); R = (st >> 1) * 16 + swz / 64; C = (st & 1) * 32 + (swz % 64) / 2; }
__host__ __device__ __forceinline__ int perm32(int rho) { const int n = rho >> 4, i = rho & 15; return 8 * (i >> 2) + 4 * n + (i & 3); }

struct Unit { int pm, pn; };
struct Gemm { const bf16_t* A; const bf16_t* Bt; int K, lda, ldb; unsigned tstepA, tstepB; unsigned agstride = 0; };

struct StaticOrder {
    int nM, nN, nwg, G, c, pm0;
    __device__ void init(int M, int N, int G_, int c_, int pm0_ = 0) { nM = M / BM; nN = N / BM; nwg = nM * nN; G = G_; c = c_; pm0 = pm0_; }
    __device__ bool next(int i, Unit& u) const {
        const long L = (long)i * G + c; if (L >= nwg) return false;
        int wgid = (int)L; { const int q = nwg / NXCD, r = nwg % NXCD, xcd = wgid % NXCD, off = wgid / NXCD; wgid = (xcd < r ? xcd * (q + 1) : r * (q + 1) + (xcd - r) * q) + off; }
        const int nig = WGM * nN, gid = wgid / nig, fm = gid * WGM, gsz = (nM - fm) < WGM ? (nM - fm) : WGM;
        u.pm = pm0 + fm + ((wgid % nig) % gsz); u.pn = (wgid % nig) / gsz; return true;
    }
};
struct BatchOrder {
    int nwg, G, c, mper, nper;
    __device__ void init(int ngroups, int mper_, int nper_, int G_, int c_) { mper = mper_; nper = nper_; nwg = ngroups * mper_ * nper_; G = G_; c = c_; }
    __device__ bool next(int i, Unit& u) const {
        const int L = i * G + c; if (L >= nwg) return false;
        const int per = mper * nper, g = L / per, r = L % per;
        u.pm = g * mper + r / nper; u.pn = g * nper + r % nper; return true;
    }
};

__device__ __forceinline__ unsigned cvt_pk_bf16(float lo, float hi) { unsigned r; asm volatile("v_cvt_pk_bf16_f32 %0, %1, %2" : "=v"(r) : "v"(lo), "v"(hi)); return r; }

typedef f32x4 Acc[2][2][4][2];

#ifndef PG8_SP2
#define PG8_SP2 true
#endif
template <class Epi, class Sched, bool ALIGN_EPI, bool SP2 = PG8_SP2>
__device__ __forceinline__ void gemm_phase(PG8_LAS unsigned char* lds, const Gemm g, const Sched& S, const Epi& E, int wave_id) {
    int tid_ = (wave_id << 6) | lane_id(); asm volatile("" : "+v"(tid_));
    const int tid = tid_, wid = __builtin_amdgcn_readfirstlane(tid >> 6), lane = tid & 63, wr = wid >> 2, wc = wid & 3, fr = lane & 15, fq = lane >> 4;
    const int K = g.K, nt = K / BK;
    unsigned voffA[2], voffB[2];
#pragma unroll
    for (int i = 0; i < 2; ++i) { int R, C; stage_rc(tid * 16 + i * 8192, R, C); const int Rb = Epi::PERM ? ((R & ~31) + perm32(R & 31)) : R;
        voffA[i] = g.agstride ? ((unsigned)(C >> 4) * g.agstride + (unsigned)(R * 16 + (C & 15))) * 2u : (unsigned)(R * g.lda + C) * 2u; voffB[i] = (unsigned)(Rb * g.ldb + C) * 2u; }
    const size_t kstep = (size_t)(BK * 2), kstepA = g.agstride ? (size_t)g.agstride * 8 : kstep;
    const size_t hstepA = g.agstride ? (size_t)HALF * 32 : (size_t)HALF * g.lda * 2, hstepB = (size_t)HALF * g.ldb * 2;
    const unsigned ldsw = (unsigned)wid * 1024u;
    const int aoff = lds_byte(wr * 64 + fr, fq * 8), boff = lds_byte(wc * 32 + fr, fq * 8);
#define PG8_SA(b, h) (((b) * 2 + (h)) * HTB)
#define PG8_SB(b, h) ((4 + (b) * 2 + (h)) * HTB)
#define PG8_STAGE(bufoff, gbase, voff) do { _Pragma("unroll") for (int _i = 0; _i < 2; ++_i) \
        __builtin_amdgcn_global_load_lds((const unsigned*)((const char*)(gbase) + (voff)[_i]), (PG8_LAS unsigned*)(lds + (bufoff) + ldsw + _i * 8192), 16, 0, 0); } while (0)
#define PG8_LDA(dst, b, h) do { _Pragma("unroll") for (int m = 0; m < 4; ++m) _Pragma("unroll") for (int k = 0; k < 2; ++k) dst[m][k] = *(const PG8_LAS bf16x8*)(lds + PG8_SA(b, h) + aoff + m * 2048 + k * 1024); } while (0)
#define PG8_LDB(dst, b, h) do { _Pragma("unroll") for (int n = 0; n < 2; ++n) _Pragma("unroll") for (int k = 0; k < 2; ++k) dst[n][k] = *(const PG8_LAS bf16x8*)(lds + PG8_SB(b, h) + boff + n * 2048 + k * 1024); } while (0)
#define PG8_MMA(ai, bj, At, Bt) do { __builtin_amdgcn_s_setprio(1); _Pragma("unroll") for (int m = 0; m < 4; ++m) _Pragma("unroll") for (int n = 0; n < 2; ++n) _Pragma("unroll") for (int k = 0; k < 2; ++k) \
        acc[ai][bj][m][n] = __builtin_amdgcn_mfma_f32_16x16x32_bf16(Bt[n][k], At[m][k], acc[ai][bj][m][n], 0, 0, 0); __builtin_amdgcn_s_setprio(0); } while (0)
#define PG8_WAIT_V(n) asm volatile("s_waitcnt vmcnt(" #n ")" ::: "memory")
#define PG8_WAIT_L(n) asm volatile("s_waitcnt lgkmcnt(" #n ")" ::: "memory")
#define PG8_BAR __builtin_amdgcn_s_barrier()
#define PG8_SCHED __builtin_amdgcn_sched_barrier(0)
    Unit cur, nxt; int ui = 0;
    if (!S.next(0, cur)) return;
    Acc acc;
#pragma unroll
    for (int a = 0; a < 2; ++a)
#pragma unroll
        for (int b = 0; b < 2; ++b)
#pragma unroll
            for (int m = 0; m < 4; ++m)
#pragma unroll
                for (int n = 0; n < 2; ++n) acc[a][b][m][n] = (f32x4){0.f, 0.f, 0.f, 0.f};
    bf16x8 At[4][2], B0[2][2], B1[2][2];
    const char* cA = (const char*)g.A + (size_t)cur.pm * g.tstepA; const char* cB = (const char*)g.Bt + (size_t)cur.pn * g.tstepB;
    if constexpr (SP2) {
    PG8_STAGE(PG8_SB(0, 0), cB, voffB); PG8_STAGE(PG8_SB(0, 1), cB + hstepB, voffB); PG8_STAGE(PG8_SA(0, 0), cA, voffA); PG8_STAGE(PG8_SA(0, 1), cA + hstepA, voffA);
    if (wr == 1) PG8_BAR;
    PG8_WAIT_V(2); PG8_BAR;
    PG8_STAGE(PG8_SB(1, 0), cB + kstep, voffB); PG8_STAGE(PG8_SA(1, 0), cA + kstepA, voffA); PG8_STAGE(PG8_SB(1, 1), cB + hstepB + kstep, voffB);
    PG8_WAIT_V(6); PG8_BAR;
    } else {
    PG8_STAGE(PG8_SB(0, 0), cB, voffB); PG8_STAGE(PG8_SA(0, 0), cA, voffA); PG8_STAGE(PG8_SB(0, 1), cB + hstepB, voffB); PG8_STAGE(PG8_SA(0, 1), cA + hstepA, voffA);
    if (wr == 1) PG8_BAR;
    PG8_WAIT_V(4); PG8_BAR;
    PG8_STAGE(PG8_SB(1, 0), cB + kstep, voffB); PG8_STAGE(PG8_SA(1, 0), cA + kstepA, voffA); PG8_STAGE(PG8_SB(1, 1), cB + hstepB + kstep, voffB);
    PG8_WAIT_V(6); PG8_BAR;
    }
    for (;;) {
        const bool has_next = S.next(ui + 1, nxt);
        const char* nA = has_next ? (const char*)g.A + (size_t)nxt.pm * g.tstepA : cA; const char* nB = has_next ? (const char*)g.Bt + (size_t)nxt.pn * g.tstepB : cB;
#pragma nounroll
        for (int t = 0; t < nt; t += 2) {
            const bool last = (t == nt - 2);
            const char* a1 = cA + (size_t)(t + 1) * kstepA;
            const char* a2 = last ? nA : cA + (size_t)(t + 2) * kstepA; const char* b2 = last ? nB : cB + (size_t)(t + 2) * kstep;
            const char* a3 = a2 + kstepA; const char* b3 = b2 + kstep;
            if constexpr (SP2) {
            PG8_LDB(B0, 0, 0); PG8_LDB(B1, 0, 1); PG8_SCHED; PG8_LDA(At, 0, 0); PG8_STAGE(PG8_SA(1, 1), a1 + hstepA, voffA);
            PG8_WAIT_V(8); PG8_WAIT_L(0); PG8_BAR; PG8_MMA(0, 0, At, B0); PG8_MMA(0, 1, At, B1); PG8_BAR; PG8_SCHED;
            PG8_LDA(At, 0, 1); PG8_STAGE(PG8_SB(0, 0), b2, voffB); PG8_STAGE(PG8_SB(0, 1), b2 + hstepB, voffB); PG8_STAGE(PG8_SA(0, 0), a2, voffA);
            PG8_WAIT_V(8); PG8_WAIT_L(0); PG8_BAR; PG8_MMA(1, 0, At, B0); PG8_MMA(1, 1, At, B1); PG8_BAR; PG8_SCHED;
            PG8_LDB(B0, 1, 0); PG8_LDB(B1, 1, 1); PG8_SCHED; PG8_LDA(At, 1, 0); PG8_STAGE(PG8_SA(0, 1), a2 + hstepA, voffA);
            PG8_WAIT_V(8); PG8_WAIT_L(0); PG8_BAR; PG8_MMA(0, 0, At, B0); PG8_MMA(0, 1, At, B1); PG8_BAR; PG8_SCHED;
            PG8_LDA(At, 1, 1); PG8_STAGE(PG8_SB(1, 0), b3, voffB); PG8_STAGE(PG8_SB(1, 1), b3 + hstepB, voffB); PG8_STAGE(PG8_SA(1, 0), a3, voffA);
            PG8_WAIT_V(8); PG8_WAIT_L(0); PG8_BAR; PG8_MMA(1, 0, At, B0); PG8_MMA(1, 1, At, B1); PG8_BAR; PG8_SCHED;
            } else {
            PG8_LDB(B0, 0, 0); PG8_SCHED; PG8_LDA(At, 0, 0); PG8_STAGE(PG8_SA(1, 1), a1 + hstepA, voffA);
            PG8_WAIT_L(8); PG8_BAR; PG8_WAIT_L(0); PG8_MMA(0, 0, At, B0); PG8_BAR; PG8_SCHED;
            PG8_LDB(B1, 0, 1); PG8_STAGE(PG8_SB(0, 0), b2, voffB);
            PG8_BAR; PG8_WAIT_L(0); PG8_MMA(0, 1, At, B1); PG8_BAR;
            PG8_LDA(At, 0, 1); PG8_STAGE(PG8_SA(0, 0), a2, voffA);
            PG8_BAR; PG8_WAIT_L(0); PG8_MMA(1, 0, At, B0); PG8_BAR; PG8_SCHED;
            PG8_STAGE(PG8_SB(0, 1), b2 + hstepB, voffB);
            PG8_WAIT_V(6); PG8_BAR; PG8_MMA(1, 1, At, B1); PG8_BAR;
            PG8_LDB(B0, 1, 0); PG8_SCHED; PG8_LDA(At, 1, 0); PG8_STAGE(PG8_SA(0, 1), a2 + hstepA, voffA);
            PG8_WAIT_L(8); PG8_BAR; PG8_WAIT_L(0); PG8_MMA(0, 0, At, B0); PG8_BAR; PG8_SCHED;
            PG8_LDB(B1, 1, 1); PG8_STAGE(PG8_SB(1, 0), b3, voffB);
            PG8_BAR; PG8_WAIT_L(0); PG8_MMA(0, 1, At, B1); PG8_BAR;
            PG8_LDA(At, 1, 1); PG8_STAGE(PG8_SA(1, 0), a3, voffA);
            PG8_BAR; PG8_WAIT_L(0); PG8_MMA(1, 0, At, B0); PG8_BAR; PG8_SCHED;
            PG8_STAGE(PG8_SB(1, 1), b3 + hstepB, voffB);
            PG8_WAIT_V(6); PG8_BAR; PG8_MMA(1, 1, At, B1); PG8_BAR;
            }
        }
        if constexpr (ALIGN_EPI) { if (wr == 0) PG8_BAR; }
        if constexpr (!Epi::AFTER_DRAIN) E(acc, cur, wr, wc, fr, fq);
        if (!has_next) break;
#pragma unroll
        for (int a = 0; a < 2; ++a)
#pragma unroll
            for (int b = 0; b < 2; ++b)
#pragma unroll
                for (int m = 0; m < 4; ++m)
#pragma unroll
                    for (int n = 0; n < 2; ++n) acc[a][b][m][n] = (f32x4){0.f, 0.f, 0.f, 0.f};
        cur = nxt; cA = nA; cB = nB; ++ui;
        if constexpr (ALIGN_EPI) { if (wr == 1) PG8_BAR; }
    }
    PG8_WAIT_V(0);
    if constexpr (!ALIGN_EPI) { if (wr == 0) PG8_BAR; }
    PG8_BAR;
    if constexpr (Epi::AFTER_DRAIN) E.fused(acc, cur, wr, wc, fr, fq, lds, wid, lane);
#undef PG8_SA
#undef PG8_SB
#undef PG8_STAGE
#undef PG8_LDA
#undef PG8_LDB
#undef PG8_MMA
#undef PG8_WAIT_V
#undef PG8_WAIT_L
#undef PG8_BAR
#undef PG8_SCHED
}

__device__ __forceinline__ u32x4 pack8(f32x4 a, f32x4 b) { u32x4 w; w.x = cvt_pk_bf16(a[0], a[1]); w.y = cvt_pk_bf16(a[2], a[3]); w.z = cvt_pk_bf16(b[0], b[1]); w.w = cvt_pk_bf16(b[2], b[3]); return w; }

template <int ACT  > struct EpiBf16 {
    static constexpr bool PERM = true, AFTER_DRAIN = false;
    bf16_t* O; int ldc; int gs;
    const float* ssq; float inv_n;
    int pn_mask = -1;
    __device__ __forceinline__ void operator()(const Acc& acc, const Unit& u, int wr, int wc, int fr, int fq) const {
        const int row0 = u.pm * BM + wr * 64 + fr, col0 = (u.pn & pn_mask) * 2 * gs + wc * 32 + 8 * fq;
#pragma unroll
        for (int ai = 0; ai < 2; ++ai)
#pragma unroll
            for (int m = 0; m < 4; ++m) { bf16_t* rowp = O + (size_t)(row0 + ai * HALF + m * 16) * ldc + col0;
                const float rs = ssq ? 1.0f / sqrtf(ssq[row0 + ai * HALF + m * 16] * inv_n + 1e-6f) : 1.0f;
#pragma unroll
                for (int bj = 0; bj < 2; ++bj) { f32x4 v0 = acc[ai][bj][m][0] * rs, v1 = acc[ai][bj][m][1] * rs;
                    if (ACT == 1) { v0 = __builtin_elementwise_max(v0, (f32x4){0.f, 0.f, 0.f, 0.f}); v1 = __builtin_elementwise_max(v1, (f32x4){0.f, 0.f, 0.f, 0.f}); v0 = v0 * v0; v1 = v1 * v1; }
                    if (ACT == 2) {
#pragma unroll
                        for (int j = 0; j < 4; ++j) { const float a = v0[j], za = 1.5957691216f * (a + 0.044715f * a * a * a); v0[j] = a * __builtin_amdgcn_rcpf(1.0f + __expf(-za));
                            const float b = v1[j], zb = 1.5957691216f * (b + 0.044715f * b * b * b); v1[j] = b * __builtin_amdgcn_rcpf(1.0f + __expf(-zb)); } }
                    *(u32x4*)(rowp + bj * gs) = pack8(v0, v1); } }
    }
};
struct EpiGlu {
    static constexpr bool PERM = true, AFTER_DRAIN = false;
    bf16_t* O; int ldc;
    __device__ __forceinline__ void operator()(const Acc& acc, const Unit& u, int wr, int wc, int fr, int fq) const {
        const int row0 = u.pm * BM + wr * 64 + fr, col0 = u.pn * HALF + wc * 32 + 8 * fq;
#pragma unroll
        for (int ai = 0; ai < 2; ++ai)
#pragma unroll
            for (int m = 0; m < 4; ++m) { bf16_t* rowp = O + (size_t)(row0 + ai * HALF + m * 16) * ldc + col0;
                f32x4 o[2];
#pragma unroll
                for (int n = 0; n < 2; ++n) { const f32x4 v = acc[ai][0][m][n], gt = acc[ai][1][m][n];
#pragma unroll
                    for (int j = 0; j < 4; ++j) o[n][j] = v[j] * __builtin_amdgcn_rcpf(1.0f + __expf(-gt[j])); }
                *(u32x4*)rowp = pack8(o[0], o[1]); }
    }
};
struct EpiRes {
    static constexpr bool PERM = false, AFTER_DRAIN = false;
    const float* base; float* R; int ldc; float alpha;
    __device__ __forceinline__ void operator()(const Acc& acc, const Unit& u, int wr, int wc, int fr, int fq) const {
        const int row0 = u.pm * BM + wr * 64 + fr, col0 = u.pn * BM + wc * 32 + 4 * fq;
#pragma unroll
        for (int ai = 0; ai < 2; ++ai)
#pragma unroll
            for (int m = 0; m < 4; ++m) { const size_t off = (size_t)(row0 + ai * HALF + m * 16) * ldc + col0;
                f32x4 bs[2][2];
#pragma unroll
                for (int bj = 0; bj < 2; ++bj)
#pragma unroll
                    for (int n = 0; n < 2; ++n) bs[bj][n] = *(const f32x4*)(base + off + bj * HALF + n * 16);
#pragma unroll
                for (int bj = 0; bj < 2; ++bj)
#pragma unroll
                    for (int n = 0; n < 2; ++n) *(f32x4*)(R + off + bj * HALF + n * 16) = bs[bj][n] * alpha + acc[ai][bj][m][n];
                asm volatile("" ::: "memory"); }
    }
};

struct PanelStats {
    unsigned* xbuf;
    unsigned* cnt;
    float eps;
    __device__ __forceinline__ void run(const Acc& v, const Unit& u, int wr, int wc, int fr, int fq, PG8_LAS unsigned char* lds, int wid, int lane) const {
        PG8_LAS f32x2* P = (PG8_LAS f32x2*)lds;
        PG8_LAS f32x2* S = (PG8_LAS f32x2*)(lds + 8192);
#pragma unroll
        for (int ai = 0; ai < 2; ++ai)
#pragma unroll
            for (int m = 0; m < 4; ++m) {
                float s = 0.f;
#pragma unroll
                for (int bj = 0; bj < 2; ++bj)
#pragma unroll
                    for (int n = 0; n < 2; ++n) { const f32x4 x = v[ai][bj][m][n]; s += (x[0] + x[1]) + (x[2] + x[3]); }
                s += __shfl_xor(s, 16); s += __shfl_xor(s, 32);
                const float mw = s * (1.0f / 64.0f); float q = 0.f;
#pragma unroll
                for (int bj = 0; bj < 2; ++bj)
#pragma unroll
                    for (int n = 0; n < 2; ++n) { const f32x4 d = v[ai][bj][m][n] - mw; q += (d[0] * d[0] + d[1] * d[1]) + (d[2] * d[2] + d[3] * d[3]); }
                q += __shfl_xor(q, 16); q += __shfl_xor(q, 32);
                if (fq == 0) P[(ai * HALF + wr * 64 + m * 16 + fr) * 4 + wc] = (f32x2){mw, q};
            }
        asm volatile("s_waitcnt lgkmcnt(0)" ::: "memory"); __builtin_amdgcn_s_barrier(); asm volatile("" ::: "memory");
        const int row = wid * 32 + (lane & 31);
        if (lane < 32) {
            const f32x2 a = P[row * 4 + 0], b = P[row * 4 + 1], c = P[row * 4 + 2], d = P[row * 4 + 3];
            const float mt = (a.x + b.x + c.x + d.x) * 0.25f;
            const float da = a.x - mt, db = b.x - mt, dc = c.x - mt, dd = d.x - mt;
            const float m2 = (a.y + b.y) + (c.y + d.y) + 64.0f * ((da * da + db * db) + (dc * dc + dd * dd));
            unsigned long long* slot = (unsigned long long*)xbuf + ((size_t)(u.pm * BM + row) * 4 + u.pn);
            __hip_atomic_store(slot, ((unsigned long long)__float_as_uint(m2) << 32) | __float_as_uint(mt), __ATOMIC_RELAXED, __HIP_MEMORY_SCOPE_AGENT);
        }
        asm volatile("s_waitcnt vmcnt(0)" ::: "memory");
        if (lane == 0) __hip_atomic_fetch_add(cnt + 64 * u.pm, 1u, __ATOMIC_RELAXED, __HIP_MEMORY_SCOPE_AGENT);
        if (wid == 0) {
            for (unsigned spin = 0; spin < (1u << 22); ++spin) {
                if ((unsigned)__builtin_amdgcn_readfirstlane(__hip_atomic_load(cnt + 64 * u.pm, __ATOMIC_RELAXED, __HIP_MEMORY_SCOPE_AGENT)) >= 32u) break;
                __builtin_amdgcn_s_sleep(2);
            }
            __builtin_amdgcn_fence(__ATOMIC_ACQUIRE, "agent");
        }
        asm volatile("s_waitcnt vmcnt(0) lgkmcnt(0)" ::: "memory"); __builtin_amdgcn_s_barrier(); asm volatile("" ::: "memory");
        if (lane < 32) {
            const unsigned long long* slot = (const unsigned long long*)xbuf + (size_t)(u.pm * BM + row) * 4; float mt[4], m2[4]; float ms = 0.f;
#pragma unroll
            for (int t = 0; t < 4; ++t) { const unsigned long long w = __hip_atomic_load(slot + t, __ATOMIC_RELAXED, __HIP_MEMORY_SCOPE_AGENT); mt[t] = __uint_as_float((unsigned)w); m2[t] = __uint_as_float((unsigned)(w >> 32)); ms += mt[t]; }
            const float mean = ms * 0.25f; float q = 0.f;
#pragma unroll
            for (int t = 0; t < 4; ++t) { const float dm = mt[t] - mean; q += m2[t] + 256.0f * dm * dm; }
            S[row] = (f32x2){mean, 1.0f / sqrtf(q * (1.0f / 1024.0f) + eps)};
        }
        asm volatile("s_waitcnt lgkmcnt(0)" ::: "memory"); __builtin_amdgcn_s_barrier(); asm volatile("" ::: "memory");
    }
};
template <int BASE_BF16  , bool OUT_F32> struct EpiResLn {
    static constexpr bool PERM = false, AFTER_DRAIN = false;
    const void* base; void* out; const float* gam; const float* bet; float alpha; PanelStats st; PG8_LAS unsigned char* tab;
    __device__ __forceinline__ void operator()(Acc& acc, const Unit& u, int wr, int wc, int fr, int fq) const { fused(acc, u, wr, wc, fr, fq, tab, wr * 4 + wc, lane_id()); }
    __device__ __forceinline__ void fused(Acc& acc, const Unit& u, int wr, int wc, int fr, int fq, PG8_LAS unsigned char* lds, int wid, int lane) const {
        const PG8_LAS f32x2* S = (const PG8_LAS f32x2*)(lds + 8192);
        const int col0 = u.pn * BM + wc * 32 + 4 * fq;
#pragma unroll
        for (int ai = 0; ai < 2; ++ai)
#pragma unroll
            for (int m = 0; m < 4; ++m) { const size_t off = (size_t)(u.pm * BM + ai * HALF + wr * 64 + m * 16 + fr) * 1024 + col0;
                f32x4 bs[2][2];
#pragma unroll
                for (int bj = 0; bj < 2; ++bj)
#pragma unroll
                    for (int n = 0; n < 2; ++n) {
                        if constexpr (BASE_BF16 != 0) { const int tok_ = u.pm * BM + ai * HALF + wr * 64 + m * 16 + fr, col_ = col0 + bj * HALF + n * 16;
                            const size_t boff = (BASE_BF16 == 2) ? ((size_t)(col_ >> 4) * 1024 + (tok_ >> 5)) * 640 + (tok_ & 31) * 16 + (col_ & 15) : off + bj * HALF + n * 16;
                            const f32x2 w = *(const f32x2*)((const bf16_t*)base + boff); const unsigned w0 = __float_as_uint(w.x), w1 = __float_as_uint(w.y);
                            bs[bj][n] = (f32x4){__uint_as_float(w0 << 16), __uint_as_float(w0 & 0xffff0000u), __uint_as_float(w1 << 16), __uint_as_float(w1 & 0xffff0000u)}; }
                        else bs[bj][n] = *(const f32x4*)((const float*)base + off + bj * HALF + n * 16); }
#pragma unroll
                for (int bj = 0; bj < 2; ++bj)
#pragma unroll
                    for (int n = 0; n < 2; ++n) acc[ai][bj][m][n] += bs[bj][n] * alpha;
                asm volatile("" : "+v"(acc[ai][0][m][0]), "+v"(acc[ai][0][m][1]), "+v"(acc[ai][1][m][0]), "+v"(acc[ai][1][m][1]));
                asm volatile("" ::: "memory"); }
        st.run(acc, u, wr, wc, fr, fq, lds, wid, lane);
#pragma unroll
        for (int bj = 0; bj < 2; ++bj)
#pragma unroll
            for (int n = 0; n < 2; ++n) { const int cc = col0 + bj * HALF + n * 16;
                const f32x4 gg = *(const f32x4*)(gam + cc), bb = *(const f32x4*)(bet + cc);
#pragma unroll
                for (int ai = 0; ai < 2; ++ai)
#pragma unroll
                    for (int m = 0; m < 4; ++m) { const int r = ai * HALF + wr * 64 + m * 16 + fr; const f32x2 sr = S[r]; const size_t off = (size_t)(u.pm * BM + r) * 1024 + cc;
                        const f32x4 y = (acc[ai][bj][m][n] - sr.x) * sr.y * gg + bb;
                        if constexpr (OUT_F32) *(f32x4*)((float*)out + off) = y;
                        else { f32x2 w; const unsigned w0 = cvt_pk_bf16(y[0], y[1]), w1 = cvt_pk_bf16(y[2], y[3]); w.x = __uint_as_float(w0); w.y = __uint_as_float(w1); *(f32x2*)((bf16_t*)out + off) = w; } }
                asm volatile("" ::: "memory"); }
        __builtin_amdgcn_s_barrier();
    }
};
struct EpiQKVA {
    static constexpr bool PERM = true, AFTER_DRAIN = false;
    bf16_t* CKV; bf16_t* CQ; bf16_t* KR; const float* CS; float* ssq_kv; float* ssq_q;
    __device__ __forceinline__ void operator()(const Acc& acc, const Unit& u, int wr, int wc, int fr, int fq) const {
        const int row0 = u.pm * BM + wr * 64 + fr;
        if (u.pn == 3) {
            if (wc != 0) return;
            const int i0 = 8 * fq;
#pragma unroll
            for (int ai = 0; ai < 2; ++ai)
#pragma unroll
                for (int m = 0; m < 4; ++m) { const int row = row0 + ai * HALF + m * 16;
                    f32x4 o1[2], o2[2];
#pragma unroll
                    for (int n = 0; n < 2; ++n) { const f32x4 cs = *(const f32x4*)(CS + (size_t)row * 64 + i0 + 4 * n), sn = *(const f32x4*)(CS + (size_t)row * 64 + 32 + i0 + 4 * n);
                        const f32x4 x1 = acc[ai][0][m][n], x2 = acc[ai][1][m][n];
                        o1[n] = x1 * cs - x2 * sn; o2[n] = x1 * sn + x2 * cs; }
                    bf16_t* kp = KR + (size_t)row * 64 + i0;
                    *(u32x4*)kp = pack8(o1[0], o1[1]); *(u32x4*)(kp + 32) = pack8(o2[0], o2[1]); }
            return;
        }
        const int nbj = (u.pn == 2) ? 1 : 2;
        bf16_t* O = (u.pn == 0) ? CKV : CQ + (u.pn - 1) * 256; const int ldc = (u.pn == 0) ? 256 : 384; float* ssq = (u.pn == 0) ? ssq_kv : ssq_q;
        const int col0 = wc * 32 + 8 * fq;
#pragma unroll
        for (int ai = 0; ai < 2; ++ai)
#pragma unroll
            for (int m = 0; m < 4; ++m) { const int row = row0 + ai * HALF + m * 16; float s = 0.f;
#pragma unroll
                for (int bj = 0; bj < 2; ++bj) if (bj < nbj) { const f32x4 v0 = acc[ai][bj][m][0], v1 = acc[ai][bj][m][1];
                    s += (v0[0] * v0[0] + v0[1] * v0[1]) + (v0[2] * v0[2] + v0[3] * v0[3]) + (v1[0] * v1[0] + v1[1] * v1[1]) + (v1[2] * v1[2] + v1[3] * v1[3]);
                    *(u32x4*)(O + (size_t)row * ldc + col0 + bj * HALF) = pack8(v0, v1); }
                s += __shfl_xor(s, 16); s += __shfl_xor(s, 32);
                if (fq == 0) atomicAdd(ssq + row, s); }
    }
};
struct EpiS1 {
    static constexpr bool PERM = false, AFTER_DRAIN = false;
    float* E;
    __device__ __forceinline__ void operator()(const Acc& acc, const Unit& u, int wr, int wc, int fr, int fq) const {
        const int row0 = u.pm * BM + wr * 64 + fr, col0 = wc * 32 + 4 * fq;
#pragma unroll
        for (int ai = 0; ai < 2; ++ai)
#pragma unroll
            for (int m = 0; m < 4; ++m) { const size_t off = (size_t)(row0 + ai * HALF + m * 16) * 128 + col0;
#pragma unroll
                for (int n = 0; n < 2; ++n) *(f32x4*)(E + off + n * 16) = acc[ai][0][m][n]; }
    }
};
struct EpiS3 {
    static constexpr bool PERM = true, AFTER_DRAIN = false;
    bf16_t* Y;
    __device__ __forceinline__ void operator()(const Acc& acc, const Unit& u, int wr, int wc, int fr, int fq) const {
        const int g = u.pm >> 2, rloc = (u.pm & 3) * BM + wr * 64 + fr;
        const int co0 = 8 * (fq & 1);
#pragma unroll
        for (int ai = 0; ai < 2; ++ai)
#pragma unroll
            for (int m = 0; m < 4; ++m) { const int r = rloc + ai * HALF + m * 16;
#pragma unroll
                for (int bj = 0; bj < 2; ++bj) { const int t = 16 * (u.pn & 1) + 8 * bj + 2 * wc + (fq >> 1);
                    f32x4 o[2];
#pragma unroll
                    for (int n = 0; n < 2; ++n)
#pragma unroll
                        for (int j = 0; j < 4; ++j) { const float v = acc[ai][bj][m][n][j]; const float z = 1.5957691216f * (v + 0.044715f * v * v * v);
                            o[n][j] = v * __builtin_amdgcn_rcpf(1.0f + __expf(-z)); }
                    *(u32x4*)(Y + ((size_t)r * 32 + t) * 1024 + g * 16 + co0) = pack8(o[0], o[1]); } }
    }
};
struct EpiQ {
    static constexpr bool PERM = true, AFTER_DRAIN = false;
    bf16_t* Q; const float* CS; const float* ssq;
    __device__ __forceinline__ void operator()(const Acc& acc, const Unit& u, int wr, int wc, int fr, int fq) const {
        const int row0 = u.pm * BM + wr * 64 + fr;
        if (u.pn < 4) {
            const int col0 = u.pn * 384 + wc * 32 + 8 * fq;
#pragma unroll
            for (int ai = 0; ai < 2; ++ai)
#pragma unroll
                for (int m = 0; m < 4; ++m) { const int row = row0 + ai * HALF + m * 16; const float rs = 1.0f / sqrtf(ssq[row] * (1.0f / 384.0f) + 1e-6f);
                    bf16_t* rowp = Q + (size_t)row * 1536 + col0;
#pragma unroll
                    for (int bj = 0; bj < 2; ++bj) *(u32x4*)(rowp + bj * 192) = pack8(acc[ai][bj][m][0] * rs, acc[ai][bj][m][1] * rs);
                    asm volatile("" ::: "memory"); }
            return;
        }
        const int h = (u.pn - 4) * 4 + wc, i0 = 8 * fq;
#pragma unroll
        for (int ai = 0; ai < 2; ++ai)
#pragma unroll
            for (int m = 0; m < 4; ++m) { const int row = row0 + ai * HALF + m * 16;
                f32x4 o1[2], o2[2]; const float rs = 1.0f / sqrtf(ssq[row] * (1.0f / 384.0f) + 1e-6f);
#pragma unroll
                for (int n = 0; n < 2; ++n) { const f32x4 cs = *(const f32x4*)(CS + (size_t)row * 64 + i0 + 4 * n), sn = *(const f32x4*)(CS + (size_t)row * 64 + 32 + i0 + 4 * n);
                    const f32x4 x1 = acc[ai][0][m][n] * rs, x2 = acc[ai][1][m][n] * rs;
                    o1[n] = x1 * cs - x2 * sn; o2[n] = x1 * sn + x2 * cs; }
                bf16_t* qp = Q + (size_t)row * 1536 + h * 192 + 128 + i0;
                *(u32x4*)qp = pack8(o1[0], o1[1]); *(u32x4*)(qp + 32) = pack8(o2[0], o2[1]);
                asm volatile("" ::: "memory"); }
    }
};

struct EpiS1Scan {
    static constexpr bool PERM = false, AFTER_DRAIN = true;
    bf16_t* Xg; const float* AL;
    __device__ __forceinline__ void fused(Acc& acc, const Unit& u, int wr, int wc, int fr, int fq, PG8_LAS unsigned char* lds, int wid, int lane) const {
        constexpr int ES = 132;
        PG8_LAS float* E = (PG8_LAS float*)lds;
#pragma unroll
        for (int ai = 0; ai < 2; ++ai)
#pragma unroll
            for (int m = 0; m < 4; ++m) { const int row = ai * HALF + wr * 64 + m * 16 + fr;
#pragma unroll
                for (int n = 0; n < 2; ++n) *(PG8_LAS f32x4*)(E + row * ES + wc * 32 + n * 16 + 4 * fq) = acc[ai][0][m][n]; }
        asm volatile("s_waitcnt lgkmcnt(0)" ::: "memory"); __builtin_amdgcn_s_barrier(); asm volatile("" ::: "memory");
        if (wid < 2) {
            const int g = u.pm >> 2, b = 2 * (u.pm & 3) + wid, p = lane;
            const float ar = AL[(g * 64 + p) * 2], ai_ = AL[(g * 64 + p) * 2 + 1];
            float hr = 0.f, hi = 0.f;
            const PG8_LAS float* Ep = E + (wid * 128) * ES + p;
            bf16_t* Hp = Xg + ((size_t)g * 1024 + b * 128) * 640 + 512 + p;
            for (int c0 = 0; c0 < 128; c0 += 16) {
                float er[16], ei[16];
#pragma unroll
                for (int k = 0; k < 16; ++k) { er[k] = Ep[(c0 + k) * ES]; ei[k] = Ep[(c0 + k) * ES + 64]; }
#pragma unroll
                for (int k = 0; k < 16; ++k) { const unsigned ph = cvt_pk_bf16(hr, hi); Hp[(size_t)(c0 + k) * 640] = (bf16_t)(ph & 0xffffu); Hp[(size_t)(c0 + k) * 640 + 64] = (bf16_t)(ph >> 16);
                    const float nr = ar * hr - ai_ * hi + er[k], ni = ar * hi + ai_ * hr + ei[k]; hr = nr; hi = ni; }
            }
        }
        asm volatile("s_waitcnt vmcnt(0) lgkmcnt(0)" ::: "memory"); __builtin_amdgcn_s_barrier(); asm volatile("" ::: "memory");
    }
};
struct PairOrder {
    int pmg;
    __device__ bool next(int i, Unit& u) const { if (i >= 2) return false; u.pm = pmg; u.pn = (pmg >> 2) * 2 + i; return true; }
};
}

namespace att {
using bf16 = __hip_bfloat16;
typedef short bf16x8 __attribute__((ext_vector_type(8)));
typedef short s16x4 __attribute__((ext_vector_type(4)));
typedef float f32x16 __attribute__((ext_vector_type(16)));
typedef float f32x4 __attribute__((ext_vector_type(4)));
typedef unsigned u32x4 __attribute__((ext_vector_type(4)));
constexpr int NW = 8, QBLK = 32, KVBLK = 64, QB = NW * QBLK, DV = 128, DK = 192;
constexpr int SEQ = 4096, NQB = SEQ / QB;
constexpr int QS = 1536, KVS = 2048, KRS = 64, OS = 1024;
constexpr int SHM_V = KVBLK * DV * 2, SHM_K = KVBLK * DK * 2;
constexpr int NQR = 6, NQLDS = 12 - NQR, QSLOT = NQLDS * 1024;
constexpr int NVB = 3;
constexpr int WS_OFF = NVB * SHM_V + 2 * SHM_K, QR_OFF = WS_OFF + NW * 64 * 4, LDS_BYTES = QR_OFF + NW * QSLOT;
constexpr float SCALE = 0.07216878364870322f;
constexpr float THR = 8.f;
#define KSWZ(row, colB) ((row) * 384 + ((colB) ^ (((row) & 7) << 4)))
#define SBAR() __builtin_amdgcn_sched_barrier(0)
__device__ __forceinline__ int v_st(int k, int c) { const int kk = (k & ~0xC) | ((k & 4) << 1) | ((k & 8) >> 1); return ((kk >> 3) * 4 + (c >> 5)) * 512 + ((kk & 7) * 32 + (c & 31)) * 2; }
__device__ __forceinline__ int v_rd_base(int lane) { return ((lane & 3) << 3) | (((lane >> 2) & 3) << 6) | (((lane >> 4) & 1) << 5) | (((lane >> 5) & 1) << 8); }
constexpr int v_rd_off(int d0, int ks, int half) { return d0 * 512 + ks * 4096 + half * 2048; }
__device__ __forceinline__ int crow(int r, int hi) { return (r & 3) + 8 * (r >> 2) + 4 * hi; }
__device__ __forceinline__ unsigned cvtpk(float lo, float hi) { unsigned r; asm volatile("v_cvt_pk_bf16_f32 %0, %1, %2" : "=v"(r) : "v"(lo), "v"(hi)); return r; }
__device__ __forceinline__ bf16x8 load8(const bf16* p) { return *reinterpret_cast<const bf16x8*>(p); }
__device__ __forceinline__ void mask_tile(f32x16& p0, f32x16& p1, int dq, unsigned W) {
    const float NEG = -__builtin_inff();
#pragma unroll
    for (int r = 0; r < 16; ++r) {
        const int c = (r & 3) + 8 * (r >> 2);
        if ((unsigned)(dq - c) >= W) p0[r] = NEG;
        if ((unsigned)(dq - c - 32) >= W) p1[r] = NEG;
    }
}
__device__ __forceinline__ void partialSM(f32x16& p0, f32x16& p1, float& m_reg, float& mn, float& alpha) {
    float pmax = p0[0]; for (int r = 1; r < 16; ++r) pmax = fmaxf(pmax, p0[r]); for (int r = 0; r < 16; ++r) pmax = fmaxf(pmax, p1[r]);
    { auto rr = __builtin_amdgcn_permlane32_swap(__float_as_uint(pmax), __float_as_uint(pmax), false, false);
      pmax = fmaxf(__uint_as_float(rr[0]), __uint_as_float(rr[1])); }
    constexpr float C2 = 1.4426950408889634f * SCALE;
    if (__builtin_expect(__all((pmax - m_reg) * SCALE <= THR), 1)) { mn = m_reg; alpha = 1.f; }
    else { mn = fmaxf(m_reg, pmax); alpha = __builtin_amdgcn_exp2f((m_reg - mn) * C2); m_reg = mn; }
    const float mnL = -mn * C2;
    for (int r = 0; r < 16; ++r) p0[r] = fmaf(p0[r], C2, mnL); for (int r = 0; r < 16; ++r) p1[r] = fmaf(p1[r], C2, mnL);
    for (int r = 0; r < 16; ++r) p0[r] = __builtin_amdgcn_exp2f(p0[r]);
}
__device__ __forceinline__ void finishSM(f32x16& p0, f32x16& p1, float alpha, float& l_reg, bf16x8& pa0, bf16x8& pa1, bf16x8& pa2, bf16x8& pa3) {
    for (int r = 0; r < 16; ++r) p1[r] = __builtin_amdgcn_exp2f(p1[r]);
    float ps = 0; for (int r = 0; r < 16; ++r) ps += p0[r]; for (int r = 0; r < 16; ++r) ps += p1[r];
    { auto rr = __builtin_amdgcn_permlane32_swap(__float_as_uint(ps), __float_as_uint(ps), false, false);
      ps = __uint_as_float(rr[0]) + __uint_as_float(rr[1]); }
    l_reg = l_reg * alpha + ps;
#define PK4(P, B_, OUT) do { unsigned a0 = cvtpk(P[B_+0], P[B_+1]), a1 = cvtpk(P[B_+2], P[B_+3]);                          \
        unsigned b0 = cvtpk(P[B_+4], P[B_+5]), b1 = cvtpk(P[B_+6], P[B_+7]);                                             \
        auto r0 = __builtin_amdgcn_permlane32_swap(a0, b0, false, false); auto r1 = __builtin_amdgcn_permlane32_swap(a1, b1, false, false); \
        u32x4 w = {r0[0], r1[0], r0[1], r1[1]}; OUT = *reinterpret_cast<bf16x8*>(&w); } while (0)
    PK4(p0, 0, pa0); PK4(p0, 8, pa1); PK4(p1, 0, pa2); PK4(p1, 8, pa3);
#undef PK4
}
template <int KB>
__device__ __forceinline__ void qkt(f32x16& p0, f32x16& p1, const char* K_lds, int r32, int hi, const bf16x8* qr, const char* qrope) {
    p0 = f32x16{}; p1 = f32x16{};
    __builtin_amdgcn_s_setprio(1);
    const char* kb[4];
#pragma unroll
    for (int dd = 0; dd < 4; ++dd) kb[dd] = K_lds + KB * SHM_K + KSWZ(r32, (dd * 16 + hi * 8) * 2);
#pragma unroll
    for (int d0 = 0; d0 < NQR; ++d0) { const char* a = kb[d0 & 3] + (d0 >> 2) * 128;
        bf16x8 b0 = *reinterpret_cast<const bf16x8*>(a);
        bf16x8 b1 = *reinterpret_cast<const bf16x8*>(a + 32 * 384);
        p0 = __builtin_amdgcn_mfma_f32_32x32x16_bf16(b0, qr[d0], p0, 0, 0, 0);
        p1 = __builtin_amdgcn_mfma_f32_32x32x16_bf16(b1, qr[d0], p1, 0, 0, 0);
        if ((d0 & 3) == 3) SBAR(); }
#pragma unroll
    for (int d0 = NQR; d0 < 12; ++d0) { const char* a = kb[d0 & 3] + (d0 >> 2) * 128;
        bf16x8 b0 = *reinterpret_cast<const bf16x8*>(a);
        bf16x8 b1 = *reinterpret_cast<const bf16x8*>(a + 32 * 384);
        bf16x8 q = *reinterpret_cast<const bf16x8*>(qrope + (d0 - NQR) * 1024);
        p0 = __builtin_amdgcn_mfma_f32_32x32x16_bf16(b0, q, p0, 0, 0, 0);
        p1 = __builtin_amdgcn_mfma_f32_32x32x16_bf16(b1, q, p1, 0, 0, 0);
        if ((d0 & 3) == 3 && d0 != 11) SBAR(); }
    __builtin_amdgcn_s_setprio(0);
}
template <int VB>
__device__ __forceinline__ void pv_tile(f32x16* o, int vb0, bf16x8 pa0, bf16x8 pa1, bf16x8 pa2, bf16x8 pa3) {
#define TRRD(dst, off) asm volatile("ds_read_b64_tr_b16 %0, %1 offset:%2" : "=&v"(dst) : "v"(vb0), "i"(off) : "memory")
#define PV_D0(d0) do { s16x4 l0, l1, l2, l3, h0, h1, h2, h3; constexpr int b_ = VB * SHM_V + v_rd_off(d0, 0, 0); \
        TRRD(l0, b_); TRRD(h0, b_ + 2048); TRRD(l1, b_ + 4096); TRRD(h1, b_ + 6144); TRRD(l2, b_ + 8192); TRRD(h2, b_ + 10240); TRRD(l3, b_ + 12288); TRRD(h3, b_ + 14336); \
        asm volatile("s_waitcnt lgkmcnt(0)" ::: "memory"); SBAR();   \
        o[d0] = __builtin_amdgcn_mfma_f32_32x32x16_bf16(pa0, (bf16x8){l0[0], l0[1], l0[2], l0[3], h0[0], h0[1], h0[2], h0[3]}, o[d0], 0, 0, 0);   \
        o[d0] = __builtin_amdgcn_mfma_f32_32x32x16_bf16(pa1, (bf16x8){l1[0], l1[1], l1[2], l1[3], h1[0], h1[1], h1[2], h1[3]}, o[d0], 0, 0, 0);   \
        o[d0] = __builtin_amdgcn_mfma_f32_32x32x16_bf16(pa2, (bf16x8){l2[0], l2[1], l2[2], l2[3], h2[0], h2[1], h2[2], h2[3]}, o[d0], 0, 0, 0);   \
        o[d0] = __builtin_amdgcn_mfma_f32_32x32x16_bf16(pa3, (bf16x8){l3[0], l3[1], l3[2], l3[3], h3[0], h3[1], h3[2], h3[3]}, o[d0], 0, 0, 0); } while (0)
    __builtin_amdgcn_s_setprio(1); PV_D0(0); PV_D0(1); PV_D0(2); PV_D0(3); __builtin_amdgcn_s_setprio(0);
#undef PV_D0
#undef TRRD
}
struct BlockRef { const bf16* Q; const bf16* K; const bf16* V; const bf16* KR; bf16* O; int P0; };
struct Tensors { const bf16* Q; const bf16* KV; const bf16* KR; bf16* O; };
__device__ __forceinline__ BlockRef mk_ref(const Tensors& T, int bh, int qb) {
    const int b = bh >> 3, h = bh & 7; BlockRef r;
    r.Q = T.Q + ((size_t)b * SEQ + (size_t)qb * QB) * QS + h * DK;
    r.K = T.KV + (size_t)b * SEQ * KVS + h * 256; r.V = r.K + 128;
    r.KR = T.KR + (size_t)b * SEQ * KRS;
    r.O = T.O + ((size_t)b * SEQ + (size_t)qb * QB) * OS + h * DV; r.P0 = qb * QB;
    return r;
}
struct Seam { bf16x8 qr[NQR]; bf16x8 st_v0, st_v1, st_k0, st_k1, st_k2; };
#define ROWK(p, k0, rr) (((p) + (size_t)(k0) * KVS) + (unsigned)((rr) * KVS + sc))
#define VMW() asm volatile("s_waitcnt vmcnt(0)" ::: "memory")
#define LBAR() asm volatile("s_waitcnt lgkmcnt(0)\n\ts_barrier" ::: "memory")
#define VMWN(n) asm volatile("s_waitcnt vmcnt(%0)" :: "i"(n) : "memory")
#define SLOAD_H(Kp, Vp, KRp, k0) do { S.st_v0 = load8(ROWK(Vp, k0, sr)); S.st_v1 = load8(ROWK(Vp, k0, 32 + sr));              \
                         S.st_k0 = load8(ROWK(Kp, k0, sr)); S.st_k1 = load8(ROWK(Kp, k0, 32 + sr)); S.st_k2 = load8(((KRp) + (size_t)(k0) * KRS) + (unsigned)(rr8 * KRS + rc8)); } while (0)
#define SWRITE_HK(bf) do { *(bf16x8*)(K_lds + (bf) * SHM_K + kws) = S.st_k0; *(bf16x8*)(K_lds + (bf) * SHM_K + kws + 32 * 384) = S.st_k1; *(bf16x8*)(K_lds + (bf) * SHM_K + kws2) = S.st_k2; } while (0)
#define SWRITE_HV(bf) do { *(bf16x8*)(V_lds + (bf) * SHM_V + vst0) = S.st_v0; *(bf16x8*)(V_lds + (bf) * SHM_V + vst1) = S.st_v1; } while (0)
#define SWRITE_H(bf) do { SWRITE_HV(bf); SWRITE_HK(bf); } while (0)
__device__ __forceinline__ void attn_prime(const BlockRef& cur, char* lds, Seam& S, int wave_id) {
    int tid_ = (wave_id << 6) | lane_id(); asm volatile("" : "+v"(tid_));
    const int tid = tid_, wid = __builtin_amdgcn_readfirstlane(tid >> 6), lane = tid & 63, r32 = lane & 31, hi = lane >> 5;
    const int sr = tid >> 4, sc = (tid & 15) * 8, kws = KSWZ(sr, sc * 2), rr8 = tid >> 3, rc8 = (tid & 7) * 8, kws2 = KSWZ(rr8, (128 + rc8) * 2); char* K_lds = lds + NVB * SHM_V;
    char* qrope = lds + QR_OFF + wid * QSLOT + lane * 16;
    const bf16* qrow = cur.Q + (size_t)(wid * QBLK + r32) * QS + hi * 8;
#pragma unroll
    for (int d0 = 0; d0 < NQR; ++d0) S.qr[d0] = load8(qrow + d0 * 16);
#pragma unroll
    for (int d0 = NQR; d0 < 12; ++d0) *(bf16x8*)(qrope + (d0 - NQR) * 1024) = load8(qrow + d0 * 16);
    SLOAD_H(cur.K, cur.V, cur.KR, 0); VMW(); SWRITE_HK(0);
    __syncthreads();
}
__device__ __forceinline__ void attn_block(const Tensors& T, int bh, int qb, int bhn, int qbn, char* lds, Seam& S, int wave_id) {
    const BlockRef cur = mk_ref(T, bh, qb);
    int tid_ = (wave_id << 6) | lane_id(); asm volatile("" : "+v"(tid_));
    const int tid = tid_, wid = __builtin_amdgcn_readfirstlane(tid >> 6), lane = tid & 63, r32 = lane & 31, hi = lane >> 5;
    constexpr int W = SEQ;
    const int NT = (cur.P0 + QB - 1) / KVBLK + 1;
    const int qlo = cur.P0 + wid * QBLK, qm = qlo + r32 - 4 * hi;
    char* V_lds = lds; char* K_lds = lds + NVB * SHM_V;
    float* ws = (float*)(lds + WS_OFF) + wid * 64; float* li_l = ws, * al_l = ws + 32;
    char* qrope = lds + QR_OFF + wid * QSLOT + lane * 16;
    float m_reg = -1e30f, l_reg = 0; f32x16 o[4] = {};
    const int sr = tid >> 4, sc = (tid & 15) * 8, vst0 = v_st(sr, sc), vst1 = v_st(32 + sr, sc), kws = KSWZ(sr, sc * 2);
    const int rr8 = tid >> 3, rc8 = (tid & 7) * 8, kws2 = KSWZ(rr8, (128 + rc8) * 2);
    const int vb0 = (int)(uintptr_t)V_lds + v_rd_base(lane);
    const bf16* Kh = cur.K; const bf16* Vh = cur.V; const bf16* KRh = cur.KR;
#define RESC(a) do { if (__any((a) < 1.f)) { if (hi == 0) al_l[r32] = (a); asm volatile("s_waitcnt lgkmcnt(0)" ::: "memory");              \
                     for (int d_ = 0; d_ < 4; ++d_) for (int r = 0; r < 16; ++r) o[d_][r] *= al_l[crow(r, hi)]; } } while (0)
#define KBASE(t) ((t) * KVBLK)
#define MASKT(P0_, P1_, t) do { const int kb_ = KBASE(t); if (kb_ + KVBLK - 1 > qlo) mask_tile(P0_, P1_, qm - kb_, (unsigned)W); } while (0)
    constexpr int NQL = NQR;
#define SEAM_K0() do { VMWN(NQL); SWRITE_HK(0); SBAR(); } while (0)
    f32x16 pA0, pA1, pB0, pB1; float mnA, mnB, alA, alB; bf16x8 pa0, pa1, pa2, pa3;
    SWRITE_HV(0); SBAR();
    if (NT > 1) { SLOAD_H(Kh, Vh, KRh, KBASE(1)); }
    SBAR(); qkt<0>(pA0, pA1, K_lds, r32, hi, S.qr, qrope);
    MASKT(pA0, pA1, 0); partialSM(pA0, pA1, m_reg, mnA, alA);
    if (NT > 1) { VMW(); SWRITE_H(1); }
    __syncthreads();
    int vr = 0;
#define HALF_STEP(PX0, PX1, mnX, alX, PY0, PY1, alY, t, KB, SB) do {                                                          \
        const int vw_ = vr >= 1 ? vr - 1 : 2;                                                                 \
        SBAR(); qkt<KB>(PX0, PX1, K_lds, r32, hi, S.qr, qrope);                                                               \
        finishSM(PY0, PY1, alY, l_reg, pa0, pa1, pa2, pa3); SBAR();                                                           \
        if ((t) + 1 < NT) { SLOAD_H(Kh, Vh, KRh, KBASE((t) + 1)); SBAR(); }                                                   \
        pv_tile<0>(o, vb0 + vr * SHM_V, pa0, pa1, pa2, pa3); MASKT(PX0, PX1, (t)); partialSM(PX0, PX1, m_reg, mnX, alX);      \
        if ((t) + 1 < NT) { VMW(); SWRITE_HK(SB); SWRITE_HV(vw_); }                                                           \
        RESC(alX); __syncthreads();                                                                                           \
        vr = vr == 2 ? 0 : vr + 1; } while (0)
    for (int t = 1; t + 1 < NT; t += 2) {
        HALF_STEP(pB0, pB1, mnB, alB, pA0, pA1, alA, t, 1, 0);
        HALF_STEP(pA0, pA1, mnA, alA, pB0, pB1, alB, t + 1, 0, 1);
    }
    const bool even = (NT & 1) == 0;
    if (even) { SBAR(); qkt<1>(pB0, pB1, K_lds, r32, hi, S.qr, qrope); SBAR(); }
    const bf16* nqrow;
    { const BlockRef nxt = mk_ref(T, bhn, qbn);
      SLOAD_H(nxt.K, nxt.V, nxt.KR, 0); SBAR();
      nqrow = nxt.Q + (size_t)(wid * QBLK + r32) * QS + hi * 8; }
#pragma unroll
    for (int d0 = 0; d0 < NQR; ++d0) S.qr[d0] = load8(nqrow + d0 * 16);
    SBAR();
    finishSM(pA0, pA1, alA, l_reg, pa0, pa1, pa2, pa3); SBAR();
    pv_tile<0>(o, vb0 + vr * SHM_V, pa0, pa1, pa2, pa3);
    if (even) { MASKT(pB0, pB1, NT - 1); partialSM(pB0, pB1, m_reg, mnB, alB); __syncthreads(); RESC(alB);
        finishSM(pB0, pB1, alB, l_reg, pa0, pa1, pa2, pa3); SBAR(); pv_tile<0>(o, vb0 + (vr == 2 ? 0 : vr + 1) * SHM_V, pa0, pa1, pa2, pa3); }
    SBAR(); SEAM_K0();
    if (hi == 0) li_l[r32] = l_reg; asm volatile("s_waitcnt lgkmcnt(0)" ::: "memory");
    float rli[16];
#pragma unroll
    for (int r = 0; r < 16; ++r) rli[r] = __builtin_amdgcn_rcpf(li_l[crow(r, hi)]);
    bf16* Ow = mk_ref(T, bh, qb).O + (size_t)(wid * QBLK) * OS;
#pragma unroll
    for (int r = 0; r < 16; ++r) { const int orow = crow(r, hi);
#pragma unroll
        for (int d0 = 0; d0 < 4; ++d0) { const float v = o[d0][r] * rli[r];
            const float vn = __shfl_xor(v, 1);
            if ((r32 & 1) == 0) *(unsigned*)(Ow + (size_t)orow * OS + d0 * 32 + r32) = cvtpk(v, vn); } }
#pragma unroll
    for (int d0 = NQR; d0 < 12; ++d0) *(bf16x8*)(qrope + (d0 - NQR) * 1024) = load8(nqrow + d0 * 16);
    __syncthreads();
#undef RESC
#undef KBASE
#undef MASKT
#undef SEAM_K0
#undef HALF_STEP
}
#undef ROWK
#undef VMW
#undef VMWN
#undef LBAR
#undef SLOAD_H
#undef SWRITE_HK
#undef SWRITE_HV
#undef SWRITE_H
__device__ __forceinline__ void attn_phase(char* lds, const Tensors& T, int G, int vcu, int wave_id) {
    constexpr int NX = NQB / 2, TOTAL = 64 * NX;
    int L = vcu; if (L >= TOTAL) return;
    int bh = L / NX, x = L % NX, pass = 0;
    Seam S;
    { const BlockRef c0 = mk_ref(T, bh, x); attn_prime(c0, lds, S, wave_id); }
#pragma nounroll
    for (;;) {
        const bool more_pass = pass == 0, more_item = L + G < TOTAL, last = !more_pass && !more_item;
        int bhn = bh, xn = x, passn = pass + 1, Ln = L;
        if (!more_pass) { passn = 0; Ln = more_item ? L + G : L; bhn = Ln / NX; xn = Ln % NX; }
        const int qb = pass ? NQB - 1 - x : x, qbn = last ? qb : (passn ? NQB - 1 - xn : xn);
        attn_block(T, bh, qb, last ? bh : bhn, qbn, lds, S, wave_id);
        if (last) break;
        bh = bhn; x = xn; pass = passn; L = Ln;
    }
}
}

constexpr int NWAVES = 8;
constexpr int BATCH = 8, SEQ = 4096, D = 1024, FF = 4096, M = BATCH * SEQ;
constexpr int NG = 64, NP = 64, CH = 32, NCH = SEQ / CH, XG_LD = 640, RPG = BATCH * NCH;
constexpr float LN_EPS = 1e-5f, RMS_EPS = 1e-6f, DN_ALPHA = 1.4142135623730951f;
constexpr size_t MiB = 1u << 20;
constexpr size_t WS_WGLU = 1 * MiB, WS_WOUT = 5 * MiB, WS_W1 = 7 * MiB, WS_W2 = 23 * MiB, WS_WQKVA = 39 * MiB, WS_WKVB = 41 * MiB, WS_WQB = 42 * MiB, WS_WO = 44 * MiB;
constexpr size_t WS_W1G = 46 * MiB, WS_TG = 55 * MiB, WS_KBUF = 95 * MiB, WS_AL = 97 * MiB, WS_XG = 98 * MiB, WS_E = 178 * MiB, WS_YACT = 210 * MiB, WS_G = 274 * MiB;
constexpr size_t WS_HB = 400 * MiB, WS_HID = 98 * MiB;
constexpr size_t WS_CQKV = 98 * MiB, WS_CKV = 194 * MiB, WS_CQ = 210 * MiB, WS_KR = 234 * MiB, WS_CS = 238 * MiB, WS_KV = 246 * MiB, WS_Q = 374 * MiB, WS_O = 98 * MiB;
constexpr size_t WS_XBUF = 470 * MiB, WS_END = 472 * MiB;
constexpr size_t CTL_CNT = 65536, CTL_SSQ = 262144, CTL_ZERO_BYTES = 524288;
constexpr int LDS_BYTES = 153600, MISC_OFF = 153600 - 1024, LNTAB_OFF = 131072;
static_assert(att::LDS_BYTES <= MISC_OFF && pg8::STAGE_BYTES <= MISC_OFF, "LDS map");

#define GAS __attribute__((address_space(1)))
#define LAS __attribute__((address_space(3)))
typedef unsigned short bf16;
typedef unsigned v4u __attribute__((ext_vector_type(4)));
typedef unsigned v2u __attribute__((ext_vector_type(2)));
typedef float f32x4 __attribute__((ext_vector_type(4)));
typedef float f32x2 __attribute__((ext_vector_type(2)));
#define LDS_WAIT() asm volatile("s_waitcnt lgkmcnt(0)" ::: "memory")
__device__ __forceinline__ unsigned pk2(float lo, float hi) { unsigned r; asm volatile("v_cvt_pk_bf16_f32 %0, %1, %2" : "=v"(r) : "v"(lo), "v"(hi)); return r; }
__device__ __forceinline__ unsigned f2bf(float f) { return pk2(f, 0.f) & 0xffffu; }
__device__ __forceinline__ float wave_sum(float v) {
#pragma unroll
    for (int o = 1; o < 64; o <<= 1) v += __shfl_xor(v, o);
    return v;
}
__device__ __forceinline__ void sincos_red(float ang, float& s, float& c) {
    const float n = rintf(ang * 0.15915494309189535f);
    float r = fmaf(-n, 6.2831854820251465f, ang); r = fmaf(-n, -1.7484556e-7f, r);
    s = sinf(r); c = cosf(r);
}
__device__ __forceinline__ void cpow_a(float lrdt, float lidt, float k, float& re, float& im) {
    const float mag = expf(k * lrdt); float s, c; sincos_red(k * lidt, s, c); re = mag * c; im = mag * s;
}


__device__ __forceinline__ const void* argp(volatile LAS unsigned* misc, int i) {
    const unsigned lo = __builtin_amdgcn_readfirstlane(misc[16 + 2 * i]), hi = __builtin_amdgcn_readfirstlane(misc[16 + 2 * i + 1]);
    return (const void*)(((unsigned long long)hi << 32) | lo);
}
#define XB_TMO      128
#define XB_XCNT(j)  (256  + 64 * (j))
#define XB_XSUB(j)  (1280 + 64 * (j))
#define XB_XGEN(j)  (2304 + 64 * (j))
#define XB_TOP      3328
#define XB_TOPGEN   3392
#define XCD_BAR_WORDS 3456
#define XB_SPIN_CAP (1u << 22)
__device__ __forceinline__ unsigned xb_ld(unsigned* p)              { return __hip_atomic_load(p, __ATOMIC_RELAXED, __HIP_MEMORY_SCOPE_AGENT); }
__device__ __forceinline__ unsigned xb_add(unsigned* p, unsigned v) { return __hip_atomic_fetch_add(p, v, __ATOMIC_RELAXED, __HIP_MEMORY_SCOPE_AGENT); }
__device__ __forceinline__ unsigned xb_xcc_id() { return (unsigned)__builtin_amdgcn_s_getreg((3 << 11) | 20) & 0xFu; }
#define XB_SPIN(cond, bar) do { unsigned _sp = 0; while (cond) { __builtin_amdgcn_s_sleep(1); \
    if ((++_sp & 255u) == 0u) { if (xb_ld(&(bar)[XB_TMO])) break; if (_sp > XB_SPIN_CAP) { atomicAdd(&(bar)[XB_TMO], 1u); break; } } } } while (0)
struct XcdBarrier { unsigned* bar; unsigned x; volatile LAS unsigned* st; };
__device__ __forceinline__ XcdBarrier xcd_barrier_post(unsigned* bar, volatile LAS unsigned* st) {
    XcdBarrier b; b.bar = bar; b.x = xb_xcc_id(); b.st = st;
    if (threadIdx.x == 0) (void)xb_add(&bar[XB_XCNT(b.x)], 1u);
    return b;
}
__device__ __forceinline__ void xcd_barrier_complete(unsigned* bar, unsigned x, unsigned& nloc, unsigned& nx) {
    const unsigned G = gridDim.x * gridDim.y * gridDim.z;
    unsigned sum, cnt, mine, sp = 0u;
    for (;;) {
        sum = 0u; cnt = 0u; mine = 0u;
#pragma unroll
        for (unsigned j = 0; j < 16; ++j) { const unsigned c = xb_ld(&bar[XB_XCNT(j)]); sum += c; cnt += (c > 0u) ? 1u : 0u; mine = (j == x) ? c : mine; }
        if (sum == G) break;
        __builtin_amdgcn_s_sleep(1);
        if ((++sp & 255u) == 0u) { if (xb_ld(&bar[XB_TMO])) break; if (sp > XB_SPIN_CAP) { atomicAdd(&bar[XB_TMO], 1u); break; } }
    }
    nloc = mine > 0u ? mine : 1u; nx = cnt > 0u ? cnt : 1u;
}
__device__ __forceinline__ void xcd_barrier(volatile LAS unsigned* misc, int wave_id) {
    asm volatile("s_waitcnt vmcnt(0)" ::: "memory");
    __syncthreads();
    if (wave_id == 0 && lane_id() == 0) {
        XcdBarrier b; b.bar = (unsigned*)argp(misc, 26); b.x = misc[10]; b.st = misc + 8;
        unsigned* bar = b.bar;
        __builtin_amdgcn_s_waitcnt(0);
        unsigned nloc = b.st[0], nx = b.st[1];
        if (nloc == 0u) { xcd_barrier_complete(bar, b.x, nloc, nx); b.st[0] = nloc; b.st[1] = nx; }
        const unsigned old = xb_add(&bar[XB_XSUB(b.x)], 1u);
        const unsigned gen = old / nloc;
        if (old + 1u == (gen + 1u) * nloc) {
            __builtin_amdgcn_fence(__ATOMIC_RELEASE, "agent");
            asm volatile("s_waitcnt vmcnt(0)" ::: "memory");
            const unsigned og = xb_add(&bar[XB_TOP], 1u);
            const unsigned tg = og / nx;
            if (og + 1u == (tg + 1u) * nx) xb_add(&bar[XB_TOPGEN], 1u);
            else XB_SPIN(xb_ld(&bar[XB_TOPGEN]) == tg, bar);
            __builtin_amdgcn_fence(__ATOMIC_ACQUIRE, "agent");
            xb_add(&bar[XB_XGEN(b.x)], 1u);
            asm volatile("s_waitcnt vmcnt(0)" ::: "memory");
        } else {
            XB_SPIN(xb_ld(&bar[XB_XGEN(b.x)]) == gen, bar);
            __builtin_amdgcn_fence(__ATOMIC_ACQUIRE, "agent");
            asm volatile("s_waitcnt vmcnt(0)" ::: "memory");
        }
    }
    __syncthreads();
}

__device__ __forceinline__ void cpow_fast(float lrdt, float lidt, float k, float& re, float& im) {
    const float mag = __expf(k * lrdt), ang = k * lidt, n = rintf(ang * 0.15915494309189535f);
    float r = fmaf(-n, 6.2831854820251465f, ang); r = fmaf(-n, -1.7484556e-7f, r);
    re = mag * __cosf(r); im = mag * __sinf(r);
}
struct Args { const void* in[25]; float* out; unsigned char* ws; };
__device__ __forceinline__ int launder_s(int v) { asm volatile("" : "+s"(v)); return v; }
__device__ __forceinline__ int launder(int v) { asm volatile("" : "+v"(v)); return v; }

__device__ __forceinline__ int map_row(int mode, int n0) {
    if (mode == 0) return n0;
    if (mode == 1) { const int gate = n0 >= 1024, c = gate ? n0 - 1024 : n0; return 256 * (c >> 7) + (gate ? 128 : 0) + (c & 127); }
    if (mode == 3) return n0 < 256 ? n0 : (n0 == 256 ? 768 : 896);
    const int h = n0 / 192, d = n0 % 192;
    if (d < 128) return h * 128 + d;
    const int half = d >= 160, i = d - 128 - 32 * half;
    return 1024 + (h >> 2) * 256 + half * 128 + (h & 3) * 32 + i;
}
__device__ __forceinline__ void transpose_item(const float* W, int K, int N, bf16* WT, int row_off, int mode, LAS float* scr, int item, int lane, const float* kgain = nullptr) {
    const int nblk = N / 32, kb = item / nblk, nb = item % nblk, k0 = 64 * kb, n0 = 32 * nb;
    float tv[32];
#pragma unroll
    for (int i = 0; i < 32; ++i) tv[i] = W[(size_t)(k0 + 2 * i + (lane >> 5)) * N + n0 + (lane & 31)];
    if (kgain) {
#pragma unroll
        for (int i = 0; i < 32; ++i) tv[i] *= kgain[k0 + 2 * i + (lane >> 5)]; }
#pragma unroll
    for (int i = 0; i < 32; ++i) scr[(2 * i + (lane >> 5)) * 33 + (lane & 31)] = tv[i];
    LDS_WAIT(); asm volatile("" ::: "memory");
    const int c = lane & 7, r0 = row_off + map_row(mode, n0);
#pragma unroll
    for (int j = 0; j < 4; ++j) { const int n = (lane >> 3) + 8 * j; const LAS float* s = scr + (8 * c) * 33 + n;
        v4u o; o.x = pk2(s[0 * 33], s[1 * 33]); o.y = pk2(s[2 * 33], s[3 * 33]); o.z = pk2(s[4 * 33], s[5 * 33]); o.w = pk2(s[6 * 33], s[7 * 33]);
        *(v4u*)(WT + (size_t)(r0 + n) * K + k0 + 8 * c) = o; }
    LDS_WAIT(); asm volatile("" ::: "memory");
}
__device__ __forceinline__ void ln_row(float* row, bf16* orow, const float* g, const float* b, int lane) {
    f32x4* xr = (f32x4*)row + lane;
    f32x4 v[4]; float s = 0.f;
#pragma unroll
    for (int j = 0; j < 4; ++j) { v[j] = xr[64 * j]; s += (v[j].x + v[j].y) + (v[j].z + v[j].w); }
    const float mean = wave_sum(s) * (1.f / D); float s2 = 0.f;
#pragma unroll
    for (int j = 0; j < 4; ++j) { v[j] = v[j] - mean; s2 += (v[j].x * v[j].x + v[j].y * v[j].y) + (v[j].z * v[j].z + v[j].w * v[j].w); }
    const float rstd = 1.f / sqrtf(wave_sum(s2) * (1.f / D) + LN_EPS);
#pragma unroll
    for (int j = 0; j < 4; ++j) { const f32x4 gg = *((const f32x4*)g + lane + 64 * j), bb = *((const f32x4*)b + lane + 64 * j);
        const f32x4 y = v[j] * rstd * gg + bb; xr[64 * j] = y;
        if (orow) { v2u w; w.x = pk2(y.x, y.y); w.y = pk2(y.z, y.w); *((v2u*)orow + lane + 64 * j) = w; } }
}

__global__ void __launch_bounds__(NWAVES * 64, 2) mega_fwd(Args args) {
    extern __shared__ __attribute__((aligned(16))) unsigned char lds[];
    cg::grid_group grid = cg::this_grid();
    LAS unsigned char* ldsl = (LAS unsigned char*)lds;
    const int wave = __builtin_amdgcn_readfirstlane((int)threadIdx.x >> 6);
#define tid ((wave << 6) | lane_id())
#define lane0 lane_id()
    const int G = gridDim.x, bx = blockIdx.x;
    const int vcu = (G % 8 == 0) ? (bx % 8) * (G / 8) + bx / 8 : bx;
    const int gw = vcu * NWAVES + wave, NGW = G * NWAVES;
    volatile LAS unsigned* MISC = (volatile LAS unsigned*)(ldsl + MISC_OFF);
    if (tid < 16) MISC[tid] = 0u;
    if (tid == 0) {
        volatile LAS unsigned long long* A = (volatile LAS unsigned long long*)(MISC + 16);
#pragma unroll
        for (int i = 0; i < 25; ++i) A[i] = (unsigned long long)args.in[i];
        A[25] = (unsigned long long)args.out; A[26] = (unsigned long long)args.ws;
    }
    __syncthreads();
    { const XcdBarrier xb0 = xcd_barrier_post((unsigned*)args.ws, MISC + 8); if (tid == 0) MISC[10] = xb0.x; }
    int n_stamp = 0;
#define STAMP() do { if (PROBE_HI > 0) { if (bx == 0 && tid == 0) ((volatile LAS unsigned long long*)(MISC + 128))[n_stamp] = __builtin_amdgcn_s_memrealtime(); ++n_stamp; } } while (0)
#define BAR() do { xcd_barrier(MISC, wave); STAMP(); } while (0)
    STAMP();
    if (gridDim.y == 7) grid.sync();
#define ARGF(i) ((const float*)argp(MISC, (i)))
#define WSP(T, off) ((T*)((unsigned char*)argp(MISC, 26) + (off)))
#define x_in ARGF(0)
#define positions ((const int*)argp(MISC, 1))
#define ln_mix_g ARGF(2)
#define ln_mix_b ARGF(3)
#define ln_ffn_g ARGF(4)
#define ln_ffn_b ARGF(5)
#define w_ff1 ARGF(6)
#define w_ff2 ARGF(7)
#define lam_re ARGF(8)
#define lam_im ARGF(9)
#define log_dt ARGF(10)
#define b_re ARGF(11)
#define b_im ARGF(12)
#define c_re ARGF(13)
#define c_im ARGF(14)
#define ssm_d ARGF(15)
#define w_glu ARGF(16)
#define w_out ARGF(17)
#define kv_w_a ARGF(18)
#define kv_norm_g ARGF(19)
#define kv_w_b ARGF(20)
#define q_w_a ARGF(21)
#define q_norm_g ARGF(22)
#define q_w_b ARGF(23)
#define attn_w_o ARGF(24)
#define R ((float*)argp(MISC, 25))
#define Wglu_t WSP(bf16, WS_WGLU)
#define Wout_t WSP(bf16, WS_WOUT)
#define W1_t WSP(bf16, WS_W1)
#define W2_t WSP(bf16, WS_W2)
#define Wqkva_t WSP(bf16, WS_WQKVA)
#define Wkvb_t WSP(bf16, WS_WKVB)
#define Wqb_t WSP(bf16, WS_WQB)
#define Wo_t WSP(bf16, WS_WO)
#define W1g WSP(bf16, WS_W1G)
#define Tg WSP(bf16, WS_TG)
#define Kbuf WSP(float, WS_KBUF)
#define AL WSP(float, WS_AL)
#define Xg WSP(bf16, WS_XG)
#define Ebuf WSP(float, WS_E)
#define Yact WSP(bf16, WS_YACT)
#define Gb WSP(bf16, WS_G)
#define Hb WSP(bf16, WS_HB)
#define HID WSP(bf16, WS_HID)
#define CQKV WSP(float, WS_CQKV)
#define CKV WSP(bf16, WS_CKV)
#define CQ WSP(bf16, WS_CQ)
#define KR WSP(bf16, WS_KR)
#define CS ((float*)argp(MISC, 25) + (size_t)24 * 1024 * 1024)
#define SSQ_KV WSP(float, CTL_SSQ)
#define SSQ_Q WSP(float, CTL_SSQ + 131072)
#define KV WSP(bf16, WS_KV)
#define Qb ((bf16*)argp(MISC, 25))
#define Ob WSP(bf16, WS_O)

#pragma nounroll
    for (int rep0_ = 0; rep0_ < (PROBE == 4 ? 2 : 1); ++rep0_) {
        const int lane = launder(lane0);
        LAS float* scr = (LAS float*)(ldsl + wave * 16384);
        constexpr int I_GLU = 16 * 64, I_OUT = 16 * 32, I_F1 = 16 * 128, I_F2 = 64 * 32, I_KVA = 16 * 10, I_QA = 16 * 12, I_KVB = 4 * 64, I_QB = 6 * 48, I_WO = 16 * 32;
        constexpr int NT_ITEMS = I_GLU + I_OUT + 2 * I_F1 + 2 * I_F2 + I_KVA + I_QA + I_KVB + I_QB + I_WO;
        for (int it = gw; it < NT_ITEMS; it += NGW) {
            int r = it;
            if (r < I_GLU) { transpose_item(w_glu, 1024, 2048, Wglu_t, 0, 1, scr, r, lane); continue; } r -= I_GLU;
            if (r < I_OUT) { transpose_item(w_out, 1024, 1024, Wout_t, 0, 0, scr, r, lane); continue; } r -= I_OUT;
            if (r < I_F1) { transpose_item(w_ff1, 1024, 4096, W1_t, 0, 0, scr, r, lane); continue; } r -= I_F1;
            if (r < I_F1) { transpose_item(w_ff1 + (size_t)1024 * 4096, 1024, 4096, W1_t + (size_t)4096 * 1024, 0, 0, scr, r, lane); continue; } r -= I_F1;
            if (r < I_F2) { transpose_item(w_ff2, 4096, 1024, W2_t, 0, 0, scr, r, lane); continue; } r -= I_F2;
            if (r < I_F2) { transpose_item(w_ff2 + (size_t)4096 * 1024, 4096, 1024, W2_t + (size_t)1024 * 4096, 0, 0, scr, r, lane); continue; } r -= I_F2;
            if (r < I_KVA) { transpose_item(kv_w_a, 1024, 320, Wqkva_t, 0, 3, scr, r, lane); continue; } r -= I_KVA;
            if (r < I_QA) { transpose_item(q_w_a, 1024, 384, Wqkva_t, 256, 0, scr, r, lane); continue; } r -= I_QA;
            if (r < I_KVB) { transpose_item(kv_w_b, 256, 2048, Wkvb_t, 0, 0, scr, r, lane, kv_norm_g); continue; } r -= I_KVB;
            if (r < I_QB) { transpose_item(q_w_b, 384, 1536, Wqb_t, 0, 2, scr, r, lane, q_norm_g); continue; } r -= I_QB;
            transpose_item(attn_w_o, 1024, 1024, Wo_t, 0, 0, scr, r, lane);
        }
        for (int i = gw * 64 + lane; i < 320 * 128; i += NGW * 64) { const int ri = i >> 7, ch = i & 127, row = ri < 128 ? 640 + ri : (ri < 224 ? 800 + (ri - 128) : 928 + (ri - 224));
            *((v4u*)(Wqkva_t + (size_t)row * 1024) + ch) = (v4u){0u, 0u, 0u, 0u}; }
        for (int i = gw * 64 + lane; i < 8192; i += NGW * 64) *((v4u*)(W1g + (size_t)NG * 128 * 512) + i) = (v4u){0u, 0u, 0u, 0u};
        for (int it = gw; it < 4096 + 2048 + 2048 + 64; it += NGW) {
            if (it < 4096) {
                const int g = it >> 6, p = it & 63;
                const float lr = lam_re[g * 64 + p], li = lam_im[g * 64 + p], dt = expf(log_dt[g]), lrdt = lr * dt, lidt = li * dt;
                float are, aim; cpow_a(lrdt, lidt, 1.f, are, aim);
                const float inv = 1.0f / (lr * lr + li * li), cre = ((are - 1.0f) * lr + aim * li) * inv, cim = (aim * lr - (are - 1.0f) * li) * inv;
                const int c = lane & 15;
                const float br = b_re[(size_t)(g * 64 + p) * 16 + c], bi = b_im[(size_t)(g * 64 + p) * 16 + c];
                const float bbre = cre * br - cim * bi, bbim = cre * bi + cim * br;
#pragma unroll
                for (int i = 0; i < 8; ++i) { const int s = (lane >> 4) + 4 * i; float pr, pi; cpow_fast(lrdt, lidt, (float)(31 - s), pr, pi);
                    W1g[(size_t)(g * 128 + p) * 512 + s * 16 + c] = (bf16)f2bf(pr * bbre - pi * bbim);
                    W1g[(size_t)(g * 128 + 64 + p) * 512 + s * 16 + c] = (bf16)f2bf(pr * bbim + pi * bbre); }
            } else if (it < 4096 + 2048) {
                const int r = it - 4096, g = r >> 5, j = r & 31;
                LAS float* sbr = scr; LAS float* sbi = scr + 1024; LAS float* scre = scr + 2048; LAS float* scim = scr + 3072;
#pragma unroll
                for (int q = 0; q < 4; ++q) { const int idx = (q * 64 + lane) * 4;
                    *(LAS f32x4*)(sbr + idx) = *(const f32x4*)(b_re + (size_t)g * 1024 + idx); *(LAS f32x4*)(sbi + idx) = *(const f32x4*)(b_im + (size_t)g * 1024 + idx);
                    *(LAS f32x4*)(scre + idx) = *(const f32x4*)(c_re + (size_t)g * 1024 + idx); *(LAS f32x4*)(scim + idx) = *(const f32x4*)(c_im + (size_t)g * 1024 + idx); }
                const int p = lane;
                const float lr = lam_re[g * 64 + p], li = lam_im[g * 64 + p], dt = expf(log_dt[g]), lrdt = lr * dt, lidt = li * dt;
                float are, aim; cpow_a(lrdt, lidt, 1.f, are, aim);
                const float inv = 1.0f / (lr * lr + li * li), cre = ((are - 1.0f) * lr + aim * li) * inv, cim = (aim * lr - (are - 1.0f) * li) * inv;
                float pr, pi; cpow_fast(lrdt, lidt, (float)j, pr, pi);
                const float zre = pr * cre - pi * cim, zim = pr * cim + pi * cre;
                LDS_WAIT(); asm volatile("" ::: "memory");
                const int ci = lane & 15, cog = lane >> 4;
                float acc4[4] = {0.f, 0.f, 0.f, 0.f};
#pragma unroll 8
                for (int pp = 0; pp < 64; ++pp) {
                    const float zr = __uint_as_float(__builtin_amdgcn_readlane(__float_as_uint(zre), pp)), zi = __uint_as_float(__builtin_amdgcn_readlane(__float_as_uint(zim), pp)), br = sbr[pp * 16 + ci], bi = sbi[pp * 16 + ci];
                    const float xr = zr * br - zi * bi, xi = zr * bi + zi * br;
#pragma unroll
                    for (int k = 0; k < 4; ++k) acc4[k] += scre[(cog + 4 * k) * 64 + pp] * xr - scim[(cog + 4 * k) * 64 + pp] * xi;
                }
#pragma unroll
                for (int k = 0; k < 4; ++k) { const int co = cog + 4 * k; float v = acc4[k]; if (j == 0 && co == ci) v += ssm_d[g * 16 + co];
                    const bf16 hv = (bf16)f2bf(v); bf16* tp = Tg + (size_t)(g * 512 + co) * XG_LD + ci;
                    for (int t = j; t < 32; ++t) tp[(size_t)t * 16 * XG_LD + (t - j) * 16] = hv;
                    for (int t = 0; t + j + 1 < 32; ++t) tp[(size_t)t * 16 * XG_LD + (t + j + 1) * 16] = (bf16)0; }
                LDS_WAIT(); asm volatile("" ::: "memory");
            } else if (it < 4096 + 4096) {
                const int r = it - 6144, g = r >> 5, t = r & 31, p = lane;
                const float lr = lam_re[g * 64 + p], li = lam_im[g * 64 + p], dt = expf(log_dt[g]);
                float pr, pi; cpow_fast(lr * dt, li * dt, (float)(t + 1), pr, pi);
#pragma unroll 4
                for (int co = 0; co < 16; ++co) { const float cr = c_re[(size_t)(g * 16 + co) * 64 + p], cim_ = c_im[(size_t)(g * 16 + co) * 64 + p];
                    bf16* rowp = Tg + (size_t)(g * 512 + t * 16 + co) * XG_LD + 512;
                    rowp[p] = (bf16)f2bf(cr * pr - cim_ * pi); rowp[64 + p] = (bf16)f2bf(-(cr * pi + cim_ * pr)); }
            } else {
                const int g = it - 8192, p = lane;
                const float lr = lam_re[g * 64 + p], li = lam_im[g * 64 + p], dt = expf(log_dt[g]);
                float pr, pi; cpow_a(lr * dt, li * dt, 32.f, pr, pi);
                AL[(g * 64 + p) * 2] = pr; AL[(g * 64 + p) * 2 + 1] = pi;
            }
        }
#define XLOAD(V, T0) do { _Pragma("unroll") for (int q = 0; q < 4; ++q) { const f32x4* src = (const f32x4*)(x_in + (size_t)((T0) + q) * D + lane * 16); \
            _Pragma("unroll") for (int e = 0; e < 4; ++e) V[q][e] = src[e]; } } while (0)
#define XPROC(V, T0) do {                                                                                                                          \
            {                                     \
                const int q = lane >> 4, i2 = (lane & 15) * 2; const float pos = (float)positions[(T0) + q];                                    \
                float sn0, cs0, sn1, cs1;                                                                                                       \
                sincos_red(pos * exp2f(-(float)i2 * (13.287712379549449f / 32.0f)), sn0, cs0); sincos_red(pos * exp2f(-(float)(i2 + 1) * (13.287712379549449f / 32.0f)), sn1, cs1); \
                float* cp = CS + (size_t)((T0) + q) * 64 + i2; *(f32x2*)cp = (f32x2){cs0, cs1}; *(f32x2*)(cp + 32) = (f32x2){sn0, sn1}; }        \
            _Pragma("unroll") for (int q = 0; q < 4; ++q) { const int tok = (T0) + q;                                                           \
                v4u o0, o1; o0.x = pk2(V[q][0].x, V[q][0].y); o0.y = pk2(V[q][0].z, V[q][0].w); o0.z = pk2(V[q][1].x, V[q][1].y); o0.w = pk2(V[q][1].z, V[q][1].w); \
                o1.x = pk2(V[q][2].x, V[q][2].y); o1.y = pk2(V[q][2].z, V[q][2].w); o1.z = pk2(V[q][3].x, V[q][3].y); o1.w = pk2(V[q][3].z, V[q][3].w); \
                v4u* dst = (v4u*)(Xg + ((size_t)lane * RPG + (tok >> 5)) * XG_LD + (tok & 31) * 16);                                            \
                dst[0] = o0; dst[1] = o1; } } while (0)
        {
            const int step = NGW * 4; int tok0 = gw * 4;
            f32x4 va[4][4], vb[4][4];
            if (tok0 < M) XLOAD(va, tok0);
            while (tok0 < M) {
                const int t1 = tok0 + step; if (t1 < M) XLOAD(vb, t1);
                XPROC(va, tok0);
                if (t1 >= M) break;
                const int t2 = t1 + step; if (t2 < M) XLOAD(va, t2);
                XPROC(vb, t1);
                tok0 = t2;
            }
        }
#undef XLOAD
#undef XPROC
    }
    BAR();
    {
        const int unit_ = launder_s(vcu);
        {
            pg8::Gemm g{Xg, W1g, 512, XG_LD, 512, (unsigned)(256 * XG_LD * 2), (unsigned)(128 * 512 * 2)};
            pg8::BatchOrder S; S.init(NG, 4, 1, G, unit_);
            pg8::EpiS1Scan E{Xg, AL};
            pg8::gemm_phase<pg8::EpiS1Scan, pg8::BatchOrder, false>(ldsl, g, S, E, wave);
        }
        __syncthreads(); __builtin_amdgcn_fence(__ATOMIC_ACQUIRE, "agent");
        if (unit_ < NG * 4) {
            pg8::Gemm g{Xg, Tg, XG_LD, XG_LD, XG_LD, (unsigned)(256 * XG_LD * 2), (unsigned)(256 * XG_LD * 2)};
            pg8::PairOrder S{unit_};
            pg8::EpiBf16<2> E{Yact, 512, 128, nullptr, 0.f, 1};
            pg8::gemm_phase<pg8::EpiBf16<2>, pg8::PairOrder, true>(ldsl, g, S, E, wave);
        }
    }
    BAR();
    {
        pg8::Gemm g{Yact, Wglu_t, 1024, 1024, 1024, (unsigned)(256 * 16 * 2), (unsigned)(256 * 1024 * 2), (unsigned)(M * 16)};
        pg8::StaticOrder S; S.init(M, 2048, G, launder_s(bx));
        pg8::EpiGlu E{Gb, 1024};
        pg8::gemm_phase<pg8::EpiGlu, pg8::StaticOrder, true>(ldsl, g, S, E, wave);
    }
    BAR();
    static_assert(LNTAB_OFF >= pg8::STAGE_BYTES && LNTAB_OFF + 10240 + 16 <= MISC_OFF, "LDS map");
#define RES_LN_GEMM(Aptr, Btptr, Kdim, BASE_BF16, OUT_F32, BASEPTR, OUTPTR, GAM, BET, BANK, ENDBAR) do {                                             \
            {   pg8::Gemm g{Aptr, Btptr, Kdim, Kdim, Kdim, (unsigned)(256 * (Kdim) * 2), (unsigned)(256 * (Kdim) * 2)};                         \
                pg8::StaticOrder S; S.init(M, 1024, G, launder_s(bx));                                                                          \
                pg8::PanelStats st{(unsigned*)WSP(unsigned char, WS_XBUF), (unsigned*)WSP(unsigned char, CTL_CNT + (size_t)(BANK) * 32768), LN_EPS}; \
                pg8::EpiResLn<BASE_BF16, OUT_F32> E{BASEPTR, OUTPTR, GAM, BET, DN_ALPHA, st, ldsl + LNTAB_OFF};                                 \
                pg8::gemm_phase<pg8::EpiResLn<BASE_BF16, OUT_F32>, pg8::StaticOrder, true>(ldsl, g, S, E, wave);                                \
            }                                                                                                                                   \
            if (ENDBAR) BAR();                                                                                                                  \
        } while (0)
    RES_LN_GEMM(Gb, Wout_t, 1024, 2, false, Xg, Hb, ln_mix_g, ln_mix_b, 0, true);
    {
        constexpr int layer = 0;
        {
            pg8::Gemm g{Hb, W1_t + (size_t)layer * 4096 * 1024, 1024, 1024, 1024, (unsigned)(256 * 1024 * 2), (unsigned)(256 * 1024 * 2)};
            pg8::StaticOrder S; S.init(M, 4096, G, launder_s(bx));
            pg8::EpiBf16<1> E{HID, 4096, 128, nullptr, 0.f};
            pg8::gemm_phase<pg8::EpiBf16<1>, pg8::StaticOrder, true>(ldsl, g, S, E, wave);
        }
        BAR();
        if constexpr (layer == 0) RES_LN_GEMM(HID, W2_t, 4096, 1, false, Hb, Hb, ln_ffn_g, ln_ffn_b, 1, true);
        else RES_LN_GEMM(HID, W2_t + (size_t)1024 * 4096, 4096, 1, true, Hb, R, ln_ffn_g + D, ln_ffn_b + D, 3, false);
        }
    {
            {
                pg8::Gemm g{Hb, Wqkva_t, 1024, 1024, 1024, (unsigned)(256 * 1024 * 2), (unsigned)(256 * 1024 * 2)};
                pg8::StaticOrder S; S.init(M, 1024, G, launder_s(bx));
                pg8::EpiQKVA E{CKV, CQ, KR, CS, SSQ_KV, SSQ_Q};
                pg8::gemm_phase<pg8::EpiQKVA, pg8::StaticOrder, true>(ldsl, g, S, E, wave);
            }
            BAR();
            {
                pg8::Gemm g{CKV, Wkvb_t, 256, 256, 256, (unsigned)(256 * 256 * 2), (unsigned)(256 * 256 * 2)};
                pg8::StaticOrder S; S.init(M, 2048, G, launder_s(bx));
                pg8::EpiBf16<0> E{KV, 2048, 128, SSQ_KV, 1.0f / 256.0f};
                pg8::gemm_phase<pg8::EpiBf16<0>, pg8::StaticOrder, true>(ldsl, g, S, E, wave);
            }
            {
                pg8::Gemm g{CQ, Wqb_t, 384, 384, 384, (unsigned)(256 * 384 * 2), (unsigned)(256 * 384 * 2)};
                pg8::StaticOrder S; S.init(M, 1536, G, launder_s(bx));
                pg8::EpiQ E{Qb, CS, SSQ_Q};
                pg8::gemm_phase<pg8::EpiQ, pg8::StaticOrder, true>(ldsl, g, S, E, wave);
            }
            BAR();
            {
                const att::Tensors T{(const att::bf16*)Qb, (const att::bf16*)KV, (const att::bf16*)KR, (att::bf16*)Ob};
#pragma nounroll
                for (int rep_ = 0; rep_ < (PROBE == 1 ? 2 : 1); ++rep_) { if (rep_) BAR(); att::attn_phase((char*)lds, T, G, launder_s(vcu), wave); }
            }
            BAR();
#if PROBE == 2
            for (int i_ = 0; i_ < 20; ++i_) BAR();
#endif
            RES_LN_GEMM(Ob, Wo_t, 1024, 1, false, Hb, Hb, ln_mix_g + D, ln_mix_b + D, 2, true);
    }
    {
        constexpr int layer = 1;
        {
            pg8::Gemm g{Hb, W1_t + (size_t)layer * 4096 * 1024, 1024, 1024, 1024, (unsigned)(256 * 1024 * 2), (unsigned)(256 * 1024 * 2)};
            pg8::StaticOrder S; S.init(M, 4096, G, launder_s(bx));
            pg8::EpiBf16<1> E{HID, 4096, 128, nullptr, 0.f};
            pg8::gemm_phase<pg8::EpiBf16<1>, pg8::StaticOrder, true>(ldsl, g, S, E, wave);
        }
        BAR();
        if constexpr (layer == 0) RES_LN_GEMM(HID, W2_t, 4096, 1, false, Hb, Hb, ln_ffn_g, ln_ffn_b, 1, true);
        else RES_LN_GEMM(HID, W2_t + (size_t)1024 * 4096, 4096, 1, true, Hb, R, ln_ffn_g + D, ln_ffn_b + D, 3, false);
        }
#undef RES_LN_GEMM
    if (PROBE_HI > 0) {
        __syncthreads(); STAMP();
        if (bx == 0 && tid == 0) { volatile LAS unsigned long long* ST = (volatile LAS unsigned long long*)(MISC + 128);
            unsigned long long d = 0; for (int k = 0; k < 24; ++k) if ((PROBE_MASK >> k) & 1u) d += ST[k + 1] - ST[k];
            d *= PROBE_MULT; const unsigned long long t0 = __builtin_amdgcn_s_memrealtime();
            while (__builtin_amdgcn_s_memrealtime() - t0 < d) __builtin_amdgcn_s_sleep(8); }
    }
}

#undef ARGF
#undef WSP
#undef x_in
#undef positions
#undef ln_mix_g
#undef ln_mix_b
#undef ln_ffn_g
#undef ln_ffn_b
#undef w_ff1
#undef w_ff2
#undef lam_re
#undef lam_im
#undef log_dt
#undef b_re
#undef b_im
#undef c_re
#undef c_im
#undef ssm_d
#undef w_glu
#undef w_out
#undef kv_w_a
#undef kv_norm_g
#undef kv_w_b
#undef q_w_a
#undef q_norm_g
#undef q_w_b
#undef attn_w_o
#undef R
#undef Wglu_t
#undef Wout_t
#undef W1_t
#undef W2_t
#undef Wqkva_t
#undef Wkvb_t
#undef Wqb_t
#undef Wo_t
#undef W1g
#undef Tg
#undef Kbuf
#undef AL
#undef Xg
#undef Ebuf
#undef Yact
#undef Gb
#undef Hb
#undef HID
#undef CQKV
#undef CKV
#undef CQ
#undef KR
#undef CS
#undef SSQ_KV
#undef SSQ_Q
#undef KV
#undef Qb
#undef Ob
extern "C" void kernel_launch(void* const* d_in, const int* in_sizes, int n_in, void* d_out, int out_size, void* d_ws, size_t ws_size, hipStream_t stream) {
    static int grid = 0;
    if (grid == 0) {
        if (n_in != 25 || in_sizes[0] != M * D || out_size != M * D || ws_size < WS_END) { fprintf(stderr, "kernel_launch: unexpected shapes (n_in %d, in0 %d, out %d, ws %zu)\n", n_in, n_in > 0 ? in_sizes[0] : -1, out_size, ws_size); grid = -1; return; }
        int dev = 0, cus = 0, per_cu = 0;
        if (hipGetDevice(&dev) != hipSuccess || hipDeviceGetAttribute(&cus, hipDeviceAttributeMultiprocessorCount, dev) != hipSuccess) { grid = -1; return; }
        if (hipFuncSetAttribute((const void*)mega_fwd, hipFuncAttributeMaxDynamicSharedMemorySize, LDS_BYTES) != hipSuccess) { fprintf(stderr, "kernel_launch: hipFuncSetAttribute failed\n"); grid = -1; return; }
        if (hipOccupancyMaxActiveBlocksPerMultiprocessor(&per_cu, (const void*)mega_fwd, NWAVES * 64, LDS_BYTES) != hipSuccess || per_cu < 1) per_cu = 1;
        (void)hipGetLastError();
        grid = cus;
        if (grid != 256) { fprintf(stderr, "kernel_launch: this kernel needs exactly 256 workgroups (one per CU of a 256-CU device); found %d CUs; nothing launched\n", cus); grid = -1; return; }
    }
    if (grid < 0) return;
    if (hipMemsetAsync(d_ws, 0, CTL_ZERO_BYTES, stream) != hipSuccess) { fprintf(stderr, "kernel_launch: hipMemsetAsync failed\n"); return; }
    Args a{};
    for (int i = 0; i < 25; ++i) a.in[i] = d_in[i];
    a.out = (float*)d_out; a.ws = (unsigned char*)d_ws;
    void* kargs[] = {&a};
    hipError_t e = hipLaunchCooperativeKernel((const void*)mega_fwd, dim3(grid), dim3(NWAVES * 64), kargs, LDS_BYTES, stream);
    if (e != hipSuccess) fprintf(stderr, "kernel_launch: cooperative launch failed: %s (grid %d)\n", hipGetErrorString(e), grid);
}
```
